# Optimizing an MI355X kernel written in HIP

```python
import math
import jax, jax.numpy as jnp
from jax import lax
import numpy as np

D_MODEL = 1024
BATCH = 2
SEQ = 8192
DEPTH = 4

N_MIXERS = 2
Q_BLOCK = 128
EPS = 1e-6
POS_OFFSET_MAX = 4096

MLA_HEADS = 16
MLA_NOPE = 64
MLA_ROPE = 32
MLA_V = 64
MLA_Q_RANK = 384
MLA_KV_RANK = 256
ROPE_BASE = 10000.0
MLA_GATE = MLA_HEADS * MLA_V
MLA_IN = MLA_Q_RANK + MLA_KV_RANK + MLA_ROPE + MLA_GATE

DIFF_HD = 64
DIFF_HEADS = D_MODEL // (2 * DIFF_HD)
DIFF_W = DIFF_HEADS * 2 * DIFF_HD
DIFF_IN = 4 * DIFF_W

N_MLA = (DEPTH + 1) // 2
N_DIFF = DEPTH // 2

kernel_name = "hybrid_mla_diffattn_adaln_encoder"


def rmsnorm(x, g):
    xf = x.astype(jnp.float32)
    y = xf * lax.rsqrt(jnp.mean(xf * xf, axis=-1, keepdims=True) + EPS)
    return (y * g.astype(jnp.float32)).astype(x.dtype)


def blockwise(fn, *arrs):
    b, s = arrs[0].shape[:2]
    nb = s // Q_BLOCK
    blocks = tuple(a.reshape((b, nb, Q_BLOCK) + a.shape[2:]).swapaxes(0, 1) for a in arrs)
    out = lax.map(fn, blocks)
    return out.swapaxes(0, 1).reshape((b, s) + out.shape[3:])


def rope_tables(positions):
    inv = ROPE_BASE ** (-jnp.arange(0, MLA_ROPE, 2, dtype=jnp.float32) / MLA_ROPE)
    ang = positions.astype(jnp.float32)[..., None] * inv
    return jnp.cos(ang), jnp.sin(ang)


def apply_rope(x, cos, sin):
    half = x.shape[-1] // 2
    x1, x2 = x[..., :half], x[..., half:]
    cos = cos.astype(x.dtype)
    sin = sin.astype(x.dtype)
    return jnp.concatenate([x1 * cos - x2 * sin, x1 * sin + x2 * cos], axis=-1)


def mla_mixer(h, positions, w_in, q_norm_g, w_q_up, kv_norm_g, w_kv_up, w_o):
    b, s, _ = h.shape
    proj = h @ w_in
    o1 = MLA_Q_RANK
    o2 = o1 + MLA_KV_RANK
    o3 = o2 + MLA_ROPE
    q_lat, kv_lat, k_rope, gate = proj[..., :o1], proj[..., o1:o2], proj[..., o2:o3], proj[..., o3:]
    q = (rmsnorm(q_lat, q_norm_g) @ w_q_up).reshape(b, s, MLA_HEADS, MLA_NOPE + MLA_ROPE)
    kv = (rmsnorm(kv_lat, kv_norm_g) @ w_kv_up).reshape(b, s, MLA_HEADS, MLA_NOPE + MLA_V)
    k_nope, v = kv[..., :MLA_NOPE], kv[..., MLA_NOPE:]
    cos, sin = rope_tables(positions)
    scale = (MLA_NOPE + MLA_ROPE) ** -0.5
    q_nope = q[..., :MLA_NOPE] * scale
    q_rope = apply_rope(q[..., MLA_NOPE:], cos[:, :, None], sin[:, :, None]) * scale
    k_rope = apply_rope(k_rope, cos, sin)

    def block(args):
        qn, qr = args
        sc = (jnp.einsum('bqhd,bkhd->bhqk', qn, k_nope)
              + jnp.einsum('bqhd,bkd->bhqk', qr, k_rope))
        p = jax.nn.softmax(sc.astype(jnp.float32), axis=-1)
        return jnp.einsum('bhqk,bkhd->bqhd', p.astype(v.dtype), v)

    o = blockwise(block, q_nope, q_rope)
    return (o.reshape(b, s, MLA_GATE) * jax.nn.silu(gate)) @ w_o


def diff_mixer(h, positions, w_in, lq1, lk1, lq2, lk2, head_g, w_o, lambda_init):
    b, s, _ = h.shape
    proj = h @ w_in
    q, k, v, gate = (proj[..., i * DIFF_W:(i + 1) * DIFF_W] for i in range(4))
    q = q.reshape(b, s, DIFF_HEADS, 2, DIFF_HD) * (DIFF_HD ** -0.5)
    k = k.reshape(b, s, DIFF_HEADS, 2, DIFF_HD)
    v = v.reshape(b, s, DIFF_HEADS, 2 * DIFF_HD)
    lam = (jnp.exp(jnp.sum(lq1.astype(jnp.float32) * lk1.astype(jnp.float32)))
           - jnp.exp(jnp.sum(lq2.astype(jnp.float32) * lk2.astype(jnp.float32)))
           + lambda_init)
    slopes = jnp.exp2(-8.0 * jnp.arange(1, DIFF_HEADS + 1, dtype=jnp.float32) / DIFF_HEADS)

    def block(args):
        qb, pb = args
        sc = jnp.einsum('bqhcd,bkhcd->bhcqk', qb, k).astype(jnp.float32)
        dist = jnp.abs(pb[:, :, None] - positions[:, None, :]).astype(jnp.float32)
        bias = -slopes[None, :, None, None, None] * dist[:, None, None]
        p = jax.nn.softmax(sc + bias, axis=-1)
        a = p[:, :, 0] - lam * p[:, :, 1]
        return jnp.einsum('bhqk,bkhd->bqhd', a.astype(v.dtype), v)

    o = blockwise(block, q, positions)
    o = rmsnorm(o, head_g) * (1.0 - lambda_init)
    return (o.reshape(b, s, DIFF_W) * jax.nn.silu(gate)) @ w_o


def setup_inputs(seed: int = 0) -> dict:
    key = jax.random.key(seed)
    ks = jax.random.split(key, 24)
    f32 = jnp.float32
    D = D_MODEL

    def nrm(k, shape, fan_in):
        return jax.random.normal(k, shape, f32) * (fan_in ** -0.5)

    def gain(k, shape):
        return 1.0 + 0.02 * jax.random.normal(k, shape, f32)

    x = jax.random.normal(ks[0], (BATCH, SEQ, D), f32)
    c = jax.random.normal(ks[1], (BATCH, D), f32)
    offs = jax.random.randint(ks[2], (BATCH, 1), 0, POS_OFFSET_MAX, dtype=jnp.int32)
    positions = (offs + jnp.arange(SEQ, dtype=jnp.int32)[None, :]).astype(jnp.int32)
    return {
        "x": x,
        "c": c,
        "positions": positions,
        "ada_w": nrm(ks[3], (DEPTH, D, 3 * D), D),
        "ada_b": 0.02 * jax.random.normal(ks[4], (DEPTH, 3 * D), f32),
        "norm_g": gain(ks[5], (DEPTH, D)),
        "mla_w_in": nrm(ks[6], (N_MLA, D, MLA_IN), D),
        "mla_q_norm_g": gain(ks[7], (N_MLA, MLA_Q_RANK)),
        "mla_w_q_up": nrm(ks[8], (N_MLA, MLA_Q_RANK, MLA_HEADS * (MLA_NOPE + MLA_ROPE)), MLA_Q_RANK),
        "mla_kv_norm_g": gain(ks[9], (N_MLA, MLA_KV_RANK)),
        "mla_w_kv_up": nrm(ks[10], (N_MLA, MLA_KV_RANK, MLA_HEADS * (MLA_NOPE + MLA_V)), MLA_KV_RANK),
        "mla_w_o": nrm(ks[11], (N_MLA, MLA_GATE, D), MLA_GATE),
        "diff_w_in": nrm(ks[12], (N_DIFF, D, DIFF_IN), D),
        "diff_lq1": 0.1 * jax.random.normal(ks[13], (N_DIFF, DIFF_HD), f32),
        "diff_lk1": 0.1 * jax.random.normal(ks[14], (N_DIFF, DIFF_HD), f32),
        "diff_lq2": 0.1 * jax.random.normal(ks[15], (N_DIFF, DIFF_HD), f32),
        "diff_lk2": 0.1 * jax.random.normal(ks[16], (N_DIFF, DIFF_HD), f32),
        "diff_head_g": gain(ks[17], (N_DIFF, 2 * DIFF_HD)),
        "diff_w_o": nrm(ks[18], (N_DIFF, DIFF_W, D), DIFF_W),
        "final_g": gain(ks[19], (D,)),
    }


def reference(x, c, positions, ada_w, ada_b, norm_g,
              mla_w_in, mla_q_norm_g, mla_w_q_up, mla_kv_norm_g, mla_w_kv_up, mla_w_o,
              diff_w_in, diff_lq1, diff_lk1, diff_lq2, diff_lk2, diff_head_g, diff_w_o,
              final_g):
    c_act = jax.nn.silu(c)
    for i in range(DEPTH):
        mod = c_act @ ada_w[i] + ada_b[i]
        shift, scale, gate = mod[:, :D_MODEL], mod[:, D_MODEL:2 * D_MODEL], mod[:, 2 * D_MODEL:]
        h = rmsnorm(x, norm_g[i]) * (1.0 + scale[:, None, :]) + shift[:, None, :]
        j = i // N_MIXERS
        if i % N_MIXERS == 0:
            y = mla_mixer(h, positions, mla_w_in[j], mla_q_norm_g[j], mla_w_q_up[j],
                          mla_kv_norm_g[j], mla_w_kv_up[j], mla_w_o[j])
        else:
            lambda_init = 0.8 - 0.6 * math.exp(-0.3 * i)
            y = diff_mixer(h, positions, diff_w_in[j], diff_lq1[j], diff_lk1[j],
                           diff_lq2[j], diff_lk2[j], diff_head_g[j], diff_w_o[j], lambda_init)
        x = x + gate[:, None, :] * y
    return rmsnorm(x, final_g)
```

```cpp
#include <hip/hip_runtime.h>
#include <hip/hip_cooperative_groups.h>
#include <cstdio>
#include <cstdint>
namespace cg = cooperative_groups;
namespace pg8 {
#define PG8_LAS __attribute__((address_space(3)))
typedef unsigned short bf16_t;
typedef short bf16x8 __attribute__((ext_vector_type(8)));
typedef float f32x4 __attribute__((ext_vector_type(4)));
typedef unsigned u32x4 __attribute__((ext_vector_type(4)));
constexpr int BM = 256, BK = 64, HALF = 128, HTB = HALF * BK * 2  , STAGE_BYTES = 8 * HTB, NXCD = 8, WGM = 8;

__host__ __device__ __forceinline__ int lds_byte(int r, int c) { const int st = (r >> 4) * 2 + (c >> 5), rr = r & 15, cc = c & 31, ob = rr * 64 + cc * 2; return st * 1024 + (ob ^ (((ob >> 9) & 1) << 5)); }
__host__ __device__ __forceinline__ void stage_rc(int b, int& R, int& C) { const int st = b / 1024, sb = b % 1024, swz = sb ^ (((sb >> 9) & 1) << 5); R = (st >> 1) * 16 + swz / 64; C = (st & 1) * 32 + (swz % 64) / 2; }
__host__ __device__ __forceinline__ int perm32(int rho) { const int n = rho >> 4, i = rho & 15; return 8 * (i >> 2) + 4 * n + (i & 3); }

struct Unit { int pm, pn; };
struct Gemm { const bf16_t* A; const bf16_t* Bt; int M, N, K, lda; };

struct StaticOrder {
    int nM, nN, nwg, G, c;
    __host__ __device__ void init(int M, int N, int G_, int c_) { nM = M / BM; nN = N / BM; nwg = nM * nN; G = G_; c = c_; }
    __host__ __device__ bool next(int i, Unit& u) const {
        const long L = (long)i * G + c; if (L >= nwg) return false;
        int wgid = (int)L; { const int q = nwg / NXCD, r = nwg % NXCD, xcd = wgid % NXCD, off = wgid / NXCD; wgid = (xcd < r ? xcd * (q + 1) : r * (q + 1) + (xcd - r) * q) + off; }
        const int nig = WGM * nN, gid = wgid / nig, fm = gid * WGM, gsz = (nM - fm) < WGM ? (nM - fm) : WGM;
        u.pm = fm + ((wgid % nig) % gsz); u.pn = (wgid % nig) / gsz; return true;
    }
    __device__ __forceinline__ void a_ready(const Unit&) const {}
    __device__ __forceinline__ void done(const Unit&) const {}
};
template <class F> struct EpiF {
    static constexpr bool PERM = F::PERM, AFTER_DRAIN = false;
    F f;
    __device__ __forceinline__ void operator()(const f32x4 (&acc)[2][2][4][2], const Unit& u, int wr, int wc, int fr, int fq) const {
        F g = f; g.launder();
#pragma unroll
        for (int ai = 0; ai < 2; ++ai)
#pragma unroll
            for (int m = 0; m < 4; ++m) { const int row = u.pm * BM + ai * HALF + wr * 64 + m * 16 + fr;
#pragma unroll
                for (int bj = 0; bj < 2; ++bj) { const int col = u.pn * BM + bj * HALF + wc * 32 + (PERM ? 8 : 4) * fq; g(row, col, acc[ai][bj][m][0], acc[ai][bj][m][1]); }
                asm volatile("" ::: "memory"); }
    }
};
template <class Epi, class Sched, bool ALIGN_EPI = false, bool SP2 = false>
__device__ __forceinline__ void gemm_phase(PG8_LAS unsigned char* lds, const Gemm g, const Sched& S, const Epi& E, const int tid) {
    const int wid = __builtin_amdgcn_readfirstlane(tid >> 6), lane = tid & 63, wr = wid >> 2, wc = wid & 3, fr = lane & 15, fq = lane >> 4;
    const int K = g.K, nt = K / BK;
    unsigned voffA[2], voffB[2];
#pragma unroll
    for (int i = 0; i < 2; ++i) { int R, C; stage_rc(tid * 16 + i * 8192, R, C); const int Rb = Epi::PERM ? ((R & ~31) + perm32(R & 31)) : R;
        voffA[i] = (unsigned)(R * g.lda + C) * 2u; voffB[i] = (unsigned)(Rb * K + C) * 2u; }
    const size_t kstep = (size_t)(BK * 2);
    const size_t hstep = (size_t)HALF * K * 2, hstepA = (size_t)HALF * g.lda * 2;
    const size_t tstep = 2 * hstep, tstepA = 2 * hstepA;
    const unsigned ldsw = (unsigned)wid * 1024u;
    const int aoff = lds_byte(wr * 64 + fr, fq * 8), boff = lds_byte(wc * 32 + fr, fq * 8);
#define PG8_SA(b, h) (((b) * 2 + (h)) * HTB)
#define PG8_SB(b, h) ((4 + (b) * 2 + (h)) * HTB)
#define PG8_STAGE(bufoff, gbase, voff) do { _Pragma("unroll") for (int _i = 0; _i < 2; ++_i) \
        __builtin_amdgcn_global_load_lds((const unsigned*)((const char*)(gbase) + (voff)[_i]), (PG8_LAS unsigned*)(lds + (bufoff) + ldsw + _i * 8192), 16, 0, 0); } while (0)
#define PG8_LDA(dst, b, h) do { _Pragma("unroll") for (int m = 0; m < 4; ++m) _Pragma("unroll") for (int k = 0; k < 2; ++k) dst[m][k] = *(const PG8_LAS bf16x8*)(lds + PG8_SA(b, h) + aoff + m * 2048 + k * 1024); } while (0)
#define PG8_LDB(dst, b, h) do { _Pragma("unroll") for (int n = 0; n < 2; ++n) _Pragma("unroll") for (int k = 0; k < 2; ++k) dst[n][k] = *(const PG8_LAS bf16x8*)(lds + PG8_SB(b, h) + boff + n * 2048 + k * 1024); } while (0)
#define PG8_MMA(ai, bj, At, Bt) do { __builtin_amdgcn_s_setprio(1); _Pragma("unroll") for (int m = 0; m < 4; ++m) _Pragma("unroll") for (int n = 0; n < 2; ++n) _Pragma("unroll") for (int k = 0; k < 2; ++k) \
        acc[ai][bj][m][n] = __builtin_amdgcn_mfma_f32_16x16x32_bf16(Bt[n][k], At[m][k], acc[ai][bj][m][n], 0, 0, 0); __builtin_amdgcn_s_setprio(0); } while (0)
#define PG8_WAIT_V(n) asm volatile("s_waitcnt vmcnt(" #n ")" ::: "memory")
#define PG8_WAIT_L(n) asm volatile("s_waitcnt lgkmcnt(" #n ")" ::: "memory")
#define PG8_BAR __builtin_amdgcn_s_barrier()
#define PG8_SCHED __builtin_amdgcn_sched_barrier(0)
    Unit cur, nxt; int ui = 0;
    if (!S.next(0, cur)) return;
    f32x4 acc[2][2][4][2];
#pragma unroll
    for (int a = 0; a < 2; ++a)
#pragma unroll
        for (int b = 0; b < 2; ++b)
#pragma unroll
            for (int m = 0; m < 4; ++m)
#pragma unroll
                for (int n = 0; n < 2; ++n) acc[a][b][m][n] = (f32x4){0.f, 0.f, 0.f, 0.f};
    bf16x8 At[4][2], B0[2][2], B1[2][2];
    const char* cA = (const char*)g.A + (size_t)cur.pm * tstepA; const char* cB = (const char*)g.Bt + (size_t)cur.pn * tstep;
    S.a_ready(cur);
    if constexpr (SP2) {
        PG8_STAGE(PG8_SB(0, 0), cB, voffB); PG8_STAGE(PG8_SB(0, 1), cB + hstep, voffB); PG8_STAGE(PG8_SA(0, 0), cA, voffA); PG8_STAGE(PG8_SA(0, 1), cA + hstepA, voffA);
        if (wr == 1) PG8_BAR;
        PG8_WAIT_V(2); PG8_BAR;
        PG8_STAGE(PG8_SB(1, 0), cB + kstep, voffB); PG8_STAGE(PG8_SA(1, 0), cA + kstep, voffA); PG8_STAGE(PG8_SB(1, 1), cB + hstep + kstep, voffB);
        PG8_WAIT_V(6); PG8_BAR;
    } else {
        PG8_STAGE(PG8_SB(0, 0), cB, voffB); PG8_STAGE(PG8_SA(0, 0), cA, voffA); PG8_STAGE(PG8_SB(0, 1), cB + hstep, voffB); PG8_STAGE(PG8_SA(0, 1), cA + hstepA, voffA);
        if (wr == 1) PG8_BAR;
        PG8_WAIT_V(4); PG8_BAR;
        PG8_STAGE(PG8_SB(1, 0), cB + kstep, voffB); PG8_STAGE(PG8_SA(1, 0), cA + kstep, voffA); PG8_STAGE(PG8_SB(1, 1), cB + hstep + kstep, voffB);
        PG8_WAIT_V(6); PG8_BAR;
    }
    for (;;) {
        const bool has_next = S.next(ui + 1, nxt);
        const char* nA = has_next ? (const char*)g.A + (size_t)nxt.pm * tstepA : cA; const char* nB = has_next ? (const char*)g.Bt + (size_t)nxt.pn * tstep : cB;
        for (int t = 0; t < nt; t += 2) {
            const bool last = (t == nt - 2);
            const char* a1 = cA + (size_t)(t + 1) * kstep;
            const char* a2 = last ? nA : cA + (size_t)(t + 2) * kstep; const char* b2 = last ? nB : cB + (size_t)(t + 2) * kstep;
            const char* a3 = a2 + kstep; const char* b3 = b2 + kstep;
            if (last && has_next) S.a_ready(nxt);
            if constexpr (SP2) {
            PG8_LDB(B0, 0, 0); PG8_LDB(B1, 0, 1); PG8_SCHED; PG8_LDA(At, 0, 0); PG8_STAGE(PG8_SA(1, 1), a1 + hstepA, voffA);
            PG8_WAIT_V(8); PG8_WAIT_L(0); PG8_BAR; PG8_MMA(0, 0, At, B0); PG8_MMA(0, 1, At, B1); PG8_BAR; PG8_SCHED;
            PG8_LDA(At, 0, 1); PG8_STAGE(PG8_SB(0, 0), b2, voffB); PG8_STAGE(PG8_SB(0, 1), b2 + hstep, voffB); PG8_STAGE(PG8_SA(0, 0), a2, voffA);
            PG8_WAIT_V(8); PG8_WAIT_L(0); PG8_BAR; PG8_MMA(1, 0, At, B0); PG8_MMA(1, 1, At, B1); PG8_BAR; PG8_SCHED;
            PG8_LDB(B0, 1, 0); PG8_LDB(B1, 1, 1); PG8_SCHED; PG8_LDA(At, 1, 0); PG8_STAGE(PG8_SA(0, 1), a2 + hstepA, voffA);
            PG8_WAIT_V(8); PG8_WAIT_L(0); PG8_BAR; PG8_MMA(0, 0, At, B0); PG8_MMA(0, 1, At, B1); PG8_BAR; PG8_SCHED;
            PG8_LDA(At, 1, 1); PG8_STAGE(PG8_SB(1, 0), b3, voffB); PG8_STAGE(PG8_SB(1, 1), b3 + hstep, voffB); PG8_STAGE(PG8_SA(1, 0), a3, voffA);
            PG8_WAIT_V(8); PG8_WAIT_L(0); PG8_BAR; PG8_MMA(1, 0, At, B0); PG8_MMA(1, 1, At, B1); PG8_BAR; PG8_SCHED;
            } else {
            PG8_LDB(B0, 0, 0); PG8_SCHED; PG8_LDA(At, 0, 0); PG8_STAGE(PG8_SA(1, 1), a1 + hstepA, voffA);
            PG8_WAIT_L(8); PG8_BAR; PG8_WAIT_L(0); PG8_MMA(0, 0, At, B0); PG8_BAR; PG8_SCHED;
            PG8_LDB(B1, 0, 1); PG8_STAGE(PG8_SB(0, 0), b2, voffB);
            PG8_BAR; PG8_WAIT_L(0); PG8_MMA(0, 1, At, B1); PG8_BAR;
            PG8_LDA(At, 0, 1); PG8_STAGE(PG8_SA(0, 0), a2, voffA);
            PG8_BAR; PG8_WAIT_L(0); PG8_MMA(1, 0, At, B0); PG8_BAR; PG8_SCHED;
            PG8_STAGE(PG8_SB(0, 1), b2 + hstep, voffB);
            PG8_WAIT_V(6); PG8_BAR; PG8_MMA(1, 1, At, B1); PG8_BAR;
            PG8_LDB(B0, 1, 0); PG8_SCHED; PG8_LDA(At, 1, 0); PG8_STAGE(PG8_SA(0, 1), a2 + hstepA, voffA);
            PG8_WAIT_L(8); PG8_BAR; PG8_WAIT_L(0); PG8_MMA(0, 0, At, B0); PG8_BAR; PG8_SCHED;
            PG8_LDB(B1, 1, 1); PG8_STAGE(PG8_SB(1, 0), b3, voffB);
            PG8_BAR; PG8_WAIT_L(0); PG8_MMA(0, 1, At, B1); PG8_BAR;
            PG8_LDA(At, 1, 1); PG8_STAGE(PG8_SA(1, 0), a3, voffA);
            PG8_BAR; PG8_WAIT_L(0); PG8_MMA(1, 0, At, B0); PG8_BAR; PG8_SCHED;
            PG8_STAGE(PG8_SB(1, 1), b3 + hstep, voffB);
            PG8_WAIT_V(6); PG8_BAR; PG8_MMA(1, 1, At, B1); PG8_BAR;
            }
        }
        if constexpr (ALIGN_EPI) { if (wr == 0) PG8_BAR; }
        if constexpr (!Epi::AFTER_DRAIN) { E(acc, cur, wr, wc, fr, fq); S.done(cur); }
        if (!has_next) break;
#pragma unroll
        for (int a = 0; a < 2; ++a)
#pragma unroll
            for (int b = 0; b < 2; ++b)
#pragma unroll
                for (int m = 0; m < 4; ++m)
#pragma unroll
                    for (int n = 0; n < 2; ++n) acc[a][b][m][n] = (f32x4){0.f, 0.f, 0.f, 0.f};
        cur = nxt; cA = nA; cB = nB; ++ui;
        if constexpr (ALIGN_EPI) { if (wr == 1) PG8_BAR; }
    }
    PG8_WAIT_V(0);
    if constexpr (!ALIGN_EPI) { if (wr == 0) PG8_BAR; }
    PG8_BAR;
    if constexpr (Epi::AFTER_DRAIN) { E.fused(acc, cur, wr, wc, fr, fq, lds, wid, lane); S.done(cur); }
#undef PG8_SA
#undef PG8_SB
#undef PG8_STAGE
#undef PG8_LDA
#undef PG8_LDB
#undef PG8_MMA
#undef PG8_WAIT_V
#undef PG8_WAIT_L
#undef PG8_BAR
#undef PG8_SCHED
}
}

constexpr int SEQ = 8192, NB = 2, M = NB * SEQ, D = 1024, DEPTH = 4;
constexpr float EPS = 1e-6f;
constexpr float LOG2E = 1.4426950408889634f;
constexpr float QSCALE_MLA = 0.10206207261596577f * LOG2E;
constexpr float QSCALE_DIFF = 0.125f * LOG2E;
constexpr int MLA_IN = 1696, MLA_IN_PAD = 1792;

typedef unsigned short bf16;
typedef float f32x4 __attribute__((ext_vector_type(4)));
typedef unsigned u32x2 __attribute__((ext_vector_type(2)));
typedef unsigned u32x4 __attribute__((ext_vector_type(4)));
#define LAS __attribute__((address_space(3)))

constexpr size_t MiB = 1u << 20;
constexpr size_t WS_MOD = 0;
constexpr size_t WS_PAR = 128 * 1024;
constexpr size_t WS_SSQ = 256 * 1024;
constexpr size_t WS_AUX = 512 * 1024;
constexpr size_t AUX_TMIN = 0, AUX_TMAX = 1024;
constexpr size_t AUX_KN2 = 4096;
constexpr size_t AUX_QN2 = AUX_KN2 + 65536;
constexpr size_t AUX_CNT = AUX_QN2 + 16384;
constexpr size_t AUX_KNM = AUX_CNT + 512;
constexpr size_t AUX_KRM = AUX_KNM + 512;
constexpr size_t AUX_ZERO_WORDS = (65536 + 16384 + 512 + 512 + 512) / 4;
constexpr size_t WS_BAR = 768 * 1024;
constexpr size_t WS_COS = 1 * MiB, WS_SIN = 2 * MiB;
constexpr size_t WS_W = 4 * MiB;
constexpr size_t W_MLA_IN = 0, W_MLA_Q = W_MLA_IN + (size_t)MLA_IN_PAD * 1024 * 2, W_MLA_KV = W_MLA_Q + (size_t)1536 * 384 * 2,
                 W_MLA_O = W_MLA_KV + (size_t)2048 * 256 * 2, W_MLA_SZ = W_MLA_O + (size_t)1024 * 1024 * 2;
constexpr size_t W_DIFF_IN = 0, W_DIFF_O = (size_t)4096 * 1024 * 2, W_DIFF_SZ = W_DIFF_O + (size_t)1024 * 1024 * 2;
constexpr size_t WS_WMLA = WS_W, WS_WDIFF = WS_W + 2 * W_MLA_SZ;
static_assert(WS_WDIFF + 2 * W_DIFF_SZ <= 40 * MiB, "weights fit");
constexpr size_t WS_HO = 40 * MiB;
constexpr size_t WS_Q = 72 * MiB;
constexpr size_t WS_STASH = 104 * MiB;
constexpr size_t WS_QL = 120 * MiB;
constexpr size_t WS_KVL = 132 * MiB;
constexpr size_t WS_KR = 140 * MiB;
constexpr size_t WS_K = 142 * MiB;
constexpr size_t WS_V = 174 * MiB;
constexpr size_t WS_G = 206 * MiB;
constexpr size_t WS_END = 238 * MiB;

constexpr int LDS_BYTES = 135168;

__device__ __forceinline__ unsigned cvtpk(float lo, float hi) { unsigned r; asm volatile("v_cvt_pk_bf16_f32 %0, %1, %2" : "=v"(r) : "v"(lo), "v"(hi)); return r; }
__device__ __forceinline__ void st4(bf16* p, f32x4 v) { u32x2 w; w.x = cvtpk(v[0], v[1]); w.y = cvtpk(v[2], v[3]); *(u32x2*)p = w; }
__device__ __forceinline__ float bf2f(bf16 b) { return __uint_as_float((unsigned)b << 16); }
__device__ __forceinline__ float silu1(float v) { return v * __builtin_amdgcn_rcpf(1.0f + __expf(-v)); }
__device__ __forceinline__ f32x4 silu4(f32x4 v) { return (f32x4){silu1(v[0]), silu1(v[1]), silu1(v[2]), silu1(v[3])}; }
__device__ __forceinline__ float dot4(f32x4 a) { return (a[0] * a[0] + a[1] * a[1]) + (a[2] * a[2] + a[3] * a[3]); }
template <int X> __device__ __forceinline__ float swz_xor(float v) { return __int_as_float(__builtin_amdgcn_ds_swizzle(__float_as_int(v), (X << 10) | 0x1f)); }
__device__ __forceinline__ float add_xor32(float v) { auto rr = __builtin_amdgcn_permlane32_swap(__float_as_uint(v), __float_as_uint(v), false, false); return __uint_as_float(rr[0]) + __uint_as_float(rr[1]); }
__device__ __forceinline__ float wave_sum(float v) {
    v += swz_xor<1>(v); v += swz_xor<2>(v); v += swz_xor<4>(v); v += swz_xor<8>(v); v += swz_xor<16>(v); return add_xor32(v);
}

__device__ __forceinline__ void st8(bf16* p, f32x4 a, f32x4 b) { u32x4 w; w.x = cvtpk(a[0], a[1]); w.y = cvtpk(a[2], a[3]); w.z = cvtpk(b[0], b[1]); w.w = cvtpk(b[2], b[3]); *(u32x4*)p = w; }
__device__ __forceinline__ void rope8(f32x4& a, f32x4& b, const float* rc_row, const float* rs_row, int ci) {
    const bool upper = ci >= 16; const int i = ci & 15;
    f32x4 pa, pb;
#pragma unroll
    for (int e = 0; e < 4; ++e) {
        auto ra = __builtin_amdgcn_permlane32_swap(__float_as_uint(a[e]), __float_as_uint(a[e]), false, false); pa[e] = __uint_as_float(upper ? ra[0] : ra[1]);
        auto rb = __builtin_amdgcn_permlane32_swap(__float_as_uint(b[e]), __float_as_uint(b[e]), false, false); pb[e] = __uint_as_float(upper ? rb[0] : rb[1]);
    }
    const f32x4 c0 = *(const f32x4*)(rc_row + i), c1 = *(const f32x4*)(rc_row + i + 4), s0 = *(const f32x4*)(rs_row + i), s1 = *(const f32x4*)(rs_row + i + 4);
    if (!upper) { a = a * c0 - pa * s0; b = b * c1 - pb * s1; }
    else { a = pa * s0 + a * c0; b = pb * s1 + b * c1; }
}
template <class T> __device__ __forceinline__ T* opaque_uniform(T* p) { asm volatile("" : "+s"(p)); return p; }
__device__ __forceinline__ int opaque_u32(unsigned v) { asm volatile("" : "+s"(v)); return (int)v; }
__device__ __forceinline__ void atomic_max_f32_filtered(unsigned* p, float v) { if (v > __uint_as_float(*(volatile unsigned*)p)) atomicMax(p, __float_as_uint(v)); }
#define LAUNDER_WS __device__ __forceinline__ void launder() { ws += (size_t)(unsigned)opaque_u32(0u); }
struct E1 {
    static constexpr bool PERM = true;
    unsigned char* ws; int j; LAUNDER_WS
    __device__ __forceinline__ void operator()(int row, int col, f32x4 a, f32x4 b) const {
        bf16 *QL = (bf16*)(ws + WS_QL), *KVL = (bf16*)(ws + WS_KVL), *KR = (bf16*)(ws + WS_KR), *G = (bf16*)(ws + WS_G);
        float *ssq_q = (float*)(ws + WS_SSQ) + (size_t)j * 2 * M, *ssq_kv = ssq_q + M; const float *rc = (const float*)(ws + WS_COS), *rs = (const float*)(ws + WS_SIN);
        const int cb = col & ~31, ci = col & 31;
        if (cb < 384) {
            st8(QL + (size_t)row * 384 + col, a, b);
            float s = dot4(a) + dot4(b); s += swz_xor<16>(s); s = add_xor32(s);
            if (ci == 0) atomicAdd(ssq_q + row, s);
        } else if (cb < 640) {
            st8(KVL + (size_t)row * 256 + (col - 384), a, b);
            float s = dot4(a) + dot4(b); s += swz_xor<16>(s); s = add_xor32(s);
            if (ci == 0) atomicAdd(ssq_kv + row, s);
        } else if (cb < 672) {
            rope8(a, b, rc + (size_t)row * 16, rs + (size_t)row * 16, ci);
            st8(KR + (size_t)row * 32 + ci, a, b);
            float n2 = dot4(a) + dot4(b); n2 += swz_xor<16>(n2); n2 = add_xor32(n2);
            n2 = fmaxf(n2, swz_xor<1>(n2)); n2 = fmaxf(n2, swz_xor<2>(n2)); n2 = fmaxf(n2, swz_xor<4>(n2)); n2 = fmaxf(n2, swz_xor<8>(n2));
            if ((ci | (row & 15)) == 0) atomic_max_f32_filtered((unsigned*)(ws + WS_AUX + AUX_KRM) + (j * 2 + (row >> 13)) * 16, n2);
        } else if (cb < MLA_IN) {
            st8(G + (size_t)row * 1024 + (col - 672), silu4(a), silu4(b));
        }
    }
};
struct E2 {
    static constexpr bool PERM = true;
    unsigned char* ws; int j; LAUNDER_WS
    __device__ __forceinline__ void operator()(int row, int col, f32x4 a, f32x4 b) const {
        bf16* Q = (bf16*)(ws + WS_Q); const float* ssq_q = (const float*)(ws + WS_SSQ) + (size_t)j * 2 * M; const float *rc = (const float*)(ws + WS_COS), *rs = (const float*)(ws + WS_SIN);
        const float r = rsqrtf(ssq_q[row] * (1.0f / 384.0f) + EPS) * QSCALE_MLA; a = a * r; b = b * r;
        const int cb = col >> 5, ci = col & 31;
        if ((cb % 3) == 2) rope8(a, b, rc + (size_t)row * 16, rs + (size_t)row * 16, ci);
        st8(Q + (size_t)row * 1536 + col, a, b);
    }
};
struct E3 {
    static constexpr bool PERM = true;
    unsigned char* ws; int j; LAUNDER_WS
    __device__ __forceinline__ void operator()(int row, int col, f32x4 a, f32x4 b) const {
        bf16 *K = (bf16*)(ws + WS_K), *V = (bf16*)(ws + WS_V); const float* ssq_kv = (const float*)(ws + WS_SSQ) + (size_t)j * 2 * M + M;
        const float r = rsqrtf(ssq_kv[row] * (1.0f / 256.0f) + EPS); a = a * r; b = b * r;
        const int head = col >> 7, w = col & 127;
        const size_t off = (size_t)row * 1024 + head * 64 + (w & 63);
        if (w < 64) { st8(K + off, a, b);
            float n2 = dot4(a) + dot4(b); n2 += swz_xor<16>(n2); n2 = add_xor32(n2);
            n2 = fmaxf(n2, swz_xor<1>(n2)); n2 = fmaxf(n2, swz_xor<2>(n2)); n2 = fmaxf(n2, swz_xor<4>(n2)); n2 = fmaxf(n2, swz_xor<8>(n2));
            if (((col & 31) | (row & 15)) == 0) atomic_max_f32_filtered((unsigned*)(ws + WS_AUX + AUX_KNM) + (j * 2 + (row >> 13)) * 32 + head * 2 + ((col >> 5) & 1), n2);
        } else st8(V + off, a, b);
    }
};
struct E4 {
    static constexpr bool PERM = false;
    unsigned char* ws; const float* xin; float* xout; int l; LAUNDER_WS
    __device__ __forceinline__ void operator()(int row, int col, f32x4 a, f32x4 b) const {
        const float* gp = (const float*)(ws + WS_MOD) + l * 6144 + 2048 + (row >> 13) * 3072 + col; const size_t off = (size_t)row * 1024 + col;
        const f32x4 g0 = *(const f32x4*)gp, g1 = *(const f32x4*)(gp + 16);
        const f32x4 x0 = *(const f32x4*)(xin + off), x1 = *(const f32x4*)(xin + off + 16);
        *(f32x4*)(xout + off) = x0 + g0 * a; *(f32x4*)(xout + off + 16) = x1 + g1 * b;
    }
};
struct E5 {
    static constexpr bool PERM = true;
    unsigned char* ws; int j; LAUNDER_WS
    __device__ __forceinline__ void operator()(int row, int col, f32x4 a, f32x4 b) const {
        bf16 *Qd = (bf16*)(ws + WS_Q), *Kd = (bf16*)(ws + WS_K), *Vd = (bf16*)(ws + WS_V), *G = (bf16*)(ws + WS_G);
        const int reg = col >> 10, c2 = col & 1023; const size_t off = (size_t)row * 1024 + c2;
        if (reg <= 1) {
            if (reg == 0) { a = a * QSCALE_DIFF; b = b * QSCALE_DIFF; st8(Qd + off, a, b); }
            else st8(Kd + off, a, b);
            float s = dot4(a) + dot4(b); s += swz_xor<16>(s); s = add_xor32(s);
            s = fmaxf(s, swz_xor<1>(s)); s = fmaxf(s, swz_xor<2>(s)); s = fmaxf(s, swz_xor<4>(s)); s = fmaxf(s, swz_xor<8>(s));
            if (((col & 31) | (row & 15)) == 0) {
                unsigned* p = (reg == 0) ? (unsigned*)(ws + WS_AUX + AUX_QN2) + ((size_t)j * 64 + (row >> 8)) * 32 + (c2 >> 5)
                                         : (unsigned*)(ws + WS_AUX + AUX_KN2) + ((size_t)j * 256 + (row >> 6)) * 32 + (c2 >> 5);
                atomic_max_f32_filtered(p, s);
            }
        }
        else if (reg == 2) st8(Vd + off, a, b);
        else st8(G + off, silu4(a), silu4(b));
    }
};

namespace att {
using bf16x8 = __attribute__((ext_vector_type(8))) short;
using s16x4 = __attribute__((ext_vector_type(4))) short;
using f32x16 = __attribute__((ext_vector_type(16))) float;
constexpr int KN_OFF = 0, KR_OFF = 9216, V_OFF = 14336, PK_OFF = 30720, BUF = 30976, WSF_OFF = 3 * BUF, ATT_LDS = WSF_OFF + 2048;
constexpr float THR = 8.0f;
#define SBAR() __builtin_amdgcn_sched_barrier(0)
__device__ __forceinline__ int crow(int r, int hi) { return (r & 3) + 8 * (r >> 2) + 4 * hi; }
template <int DVB> __device__ __forceinline__ int v_st(int k, int c) { const int kk = (k & ~0xC) | ((k & 4) << 1) | ((k & 8) >> 1); return ((kk >> 3) * DVB + (c >> 5)) * 512 + ((kk & 7) * 32 + (c & 31)) * 2; }
__device__ __forceinline__ int v_rd_base(int lane) { return ((lane & 3) << 3) | (((lane >> 2) & 3) << 6) | (((lane >> 4) & 1) << 5) | (((lane >> 5) & 1) << 8); }
template <int OFF> __device__ __forceinline__ s16x4 tr_read(int vb) { s16x4 r; asm volatile("ds_read_b64_tr_b16 %0, %1 offset:%2" : "=&v"(r) : "v"(vb), "i"(OFF) : "memory"); return r; }

template <bool BIAS>
__device__ __forceinline__ void partialSM(f32x16& p0, f32x16& p1, float& m_reg, float& alpha, const char* pkl, int hi, float pq, float cneg) {
    if constexpr (BIAS) {
#pragma unroll
        for (int i = 0; i < 4; ++i) {
            const f32x4 k0 = *(const f32x4*)(pkl + (8 * i + 4 * hi) * 4), k1 = *(const f32x4*)(pkl + (32 + 8 * i + 4 * hi) * 4);
#pragma unroll
            for (int j = 0; j < 4; ++j) { p0[4 * i + j] = fmaf(fabsf(pq - k0[j]), cneg, p0[4 * i + j]); p1[4 * i + j] = fmaf(fabsf(pq - k1[j]), cneg, p1[4 * i + j]); }
        }
    }
    float pmax = p0[0];
#pragma unroll
    for (int r = 1; r < 16; ++r) pmax = fmaxf(pmax, p0[r]);
#pragma unroll
    for (int r = 0; r < 16; ++r) pmax = fmaxf(pmax, p1[r]);
    { auto rr = __builtin_amdgcn_permlane32_swap(__float_as_uint(pmax), __float_as_uint(pmax), false, false); pmax = fmaxf(__uint_as_float(rr[0]), __uint_as_float(rr[1])); }
    float mn;
    if (__builtin_expect(__all(pmax - m_reg <= THR), 1)) { mn = m_reg; alpha = 1.f; }
    else { mn = fmaxf(m_reg, pmax); alpha = __builtin_amdgcn_exp2f(m_reg - mn); m_reg = mn; }
#pragma unroll
    for (int r = 0; r < 16; ++r) p0[r] = __builtin_amdgcn_exp2f(p0[r] - mn);
#pragma unroll
    for (int r = 0; r < 16; ++r) p1[r] = p1[r] - mn;
}
__device__ __forceinline__ void finishSM(f32x16& p0, f32x16& p1, float alpha, float& l_reg, bf16x8& pa0, bf16x8& pa1, bf16x8& pa2, bf16x8& pa3) {
#pragma unroll
    for (int r = 0; r < 16; ++r) p1[r] = __builtin_amdgcn_exp2f(p1[r]);
    float ps = 0;
#pragma unroll
    for (int r = 0; r < 16; ++r) ps += p0[r];
#pragma unroll
    for (int r = 0; r < 16; ++r) ps += p1[r];
    { auto rr = __builtin_amdgcn_permlane32_swap(__float_as_uint(ps), __float_as_uint(ps), false, false); ps = __uint_as_float(rr[0]) + __uint_as_float(rr[1]); }
    l_reg = l_reg * alpha + ps;
#define PK4(P, BASE, OUT) do { unsigned a0 = cvtpk(P[BASE + 0], P[BASE + 1]), a1 = cvtpk(P[BASE + 2], P[BASE + 3]);   \
    unsigned b0 = cvtpk(P[BASE + 4], P[BASE + 5]), b1 = cvtpk(P[BASE + 6], P[BASE + 7]);                              \
    auto r0 = __builtin_amdgcn_permlane32_swap(a0, b0, false, false); auto r1 = __builtin_amdgcn_permlane32_swap(a1, b1, false, false); \
    u32x4 w = {r0[0], r1[0], r0[1], r1[1]}; OUT = *reinterpret_cast<bf16x8*>(&w); } while (0)
    PK4(p0, 0, pa0); PK4(p0, 8, pa1); PK4(p1, 0, pa2); PK4(p1, 8, pa3);
#undef PK4
}
template <bool BIAS, bool ADDREF>
__device__ __forceinline__ void partialSM_fix(f32x16& p0, f32x16& p1, const char* pkl, int hi, float pq, float cneg, float negref) {
    if constexpr (BIAS) {
#pragma unroll
        for (int i = 0; i < 4; ++i) {
            const f32x4 k0 = *(const f32x4*)(pkl + (8 * i + 4 * hi) * 4), k1 = *(const f32x4*)(pkl + (32 + 8 * i + 4 * hi) * 4);
#pragma unroll
            for (int j = 0; j < 4; ++j) { p0[4 * i + j] = fmaf(fabsf(pq - k0[j]), cneg, p0[4 * i + j]); p1[4 * i + j] = fmaf(fabsf(pq - k1[j]), cneg, p1[4 * i + j]); }
        }
    }
    if constexpr (ADDREF) {
#pragma unroll
        for (int r = 0; r < 16; ++r) { p0[r] += negref; p1[r] += negref; }
    }
#pragma unroll
    for (int r = 0; r < 16; ++r) p0[r] = __builtin_amdgcn_exp2f(p0[r]);
}
__device__ __forceinline__ void finishSM_fix(f32x16& p0, f32x16& p1, float& l_reg, bf16x8& pa0, bf16x8& pa1, bf16x8& pa2, bf16x8& pa3) {
#pragma unroll
    for (int r = 0; r < 16; ++r) p1[r] = __builtin_amdgcn_exp2f(p1[r]);
    float ps = 0;
#pragma unroll
    for (int r = 0; r < 16; ++r) ps += p0[r];
#pragma unroll
    for (int r = 0; r < 16; ++r) ps += p1[r];
    l_reg += ps;
#define PK4(P, BASE, OUT) do { unsigned a0 = cvtpk(P[BASE + 0], P[BASE + 1]), a1 = cvtpk(P[BASE + 2], P[BASE + 3]);   \
    unsigned b0 = cvtpk(P[BASE + 4], P[BASE + 5]), b1 = cvtpk(P[BASE + 6], P[BASE + 7]);                              \
    auto r0 = __builtin_amdgcn_permlane32_swap(a0, b0, false, false); auto r1 = __builtin_amdgcn_permlane32_swap(a1, b1, false, false); \
    u32x4 w = {r0[0], r1[0], r0[1], r1[1]}; OUT = *reinterpret_cast<bf16x8*>(&w); } while (0)
    PK4(p0, 0, pa0); PK4(p0, 8, pa1); PK4(p1, 0, pa2); PK4(p1, 8, pa3);
#undef PK4
}
template <bool HASKR>
__device__ __forceinline__ void qkt(f32x16& p0, f32x16& p1, const char* buf, const bf16x8* qr, int r32, int hi, const f32x16& cinit) {
    p0 = cinit; p1 = cinit;
    const char* kb = buf + KN_OFF + r32 * 144 + hi * 16;
#pragma unroll
    for (int d0 = 0; d0 < 4; ++d0) {
        const bf16x8 b0 = *reinterpret_cast<const bf16x8*>(kb + d0 * 32);
        const bf16x8 b1 = *reinterpret_cast<const bf16x8*>(kb + 32 * 144 + d0 * 32);
        p0 = __builtin_amdgcn_mfma_f32_32x32x16_bf16(b0, qr[d0], p0, 0, 0, 0);
        p1 = __builtin_amdgcn_mfma_f32_32x32x16_bf16(b1, qr[d0], p1, 0, 0, 0);
    }
    if constexpr (HASKR) {
        const char* kr = buf + KR_OFF + r32 * 80 + hi * 16;
#pragma unroll
        for (int d0 = 0; d0 < 2; ++d0) {
            const bf16x8 b0 = *reinterpret_cast<const bf16x8*>(kr + d0 * 32);
            const bf16x8 b1 = *reinterpret_cast<const bf16x8*>(kr + 32 * 80 + d0 * 32);
            p0 = __builtin_amdgcn_mfma_f32_32x32x16_bf16(b0, qr[4 + d0], p0, 0, 0, 0);
            p1 = __builtin_amdgcn_mfma_f32_32x32x16_bf16(b1, qr[4 + d0], p1, 0, 0, 0);
        }
    }
}
template <int DVB, int D0> __device__ __forceinline__ void pv_one(f32x16& od, int vb, bf16x8 pa0, bf16x8 pa1, bf16x8 pa2, bf16x8 pa3) {
    constexpr int KS = 2 * DVB * 512, HF = DVB * 512, B0 = D0 * 512;
    const s16x4 l0 = tr_read<B0>(vb), h0 = tr_read<B0 + HF>(vb), l1 = tr_read<B0 + KS>(vb), h1 = tr_read<B0 + KS + HF>(vb);
    const s16x4 l2 = tr_read<B0 + 2 * KS>(vb), h2 = tr_read<B0 + 2 * KS + HF>(vb), l3 = tr_read<B0 + 3 * KS>(vb), h3 = tr_read<B0 + 3 * KS + HF>(vb);
    asm volatile("s_waitcnt lgkmcnt(0)" ::: "memory"); SBAR();
#define PK(L, H) (bf16x8){L[0], L[1], L[2], L[3], H[0], H[1], H[2], H[3]}
    od = __builtin_amdgcn_mfma_f32_32x32x16_bf16(pa0, PK(l0, h0), od, 0, 0, 0);
    od = __builtin_amdgcn_mfma_f32_32x32x16_bf16(pa1, PK(l1, h1), od, 0, 0, 0);
    od = __builtin_amdgcn_mfma_f32_32x32x16_bf16(pa2, PK(l2, h2), od, 0, 0, 0);
    od = __builtin_amdgcn_mfma_f32_32x32x16_bf16(pa3, PK(l3, h3), od, 0, 0, 0);
#undef PK
}
template <int DVB> __device__ __forceinline__ void pv_all(f32x16* o, int vb, bf16x8 pa0, bf16x8 pa1, bf16x8 pa2, bf16x8 pa3) {
    pv_one<DVB, 0>(o[0], vb, pa0, pa1, pa2, pa3); pv_one<DVB, 1>(o[1], vb, pa0, pa1, pa2, pa3);
    if constexpr (DVB == 4) { pv_one<DVB, 2>(o[2], vb, pa0, pa1, pa2, pa3); pv_one<DVB, 3>(o[3], vb, pa0, pa1, pa2, pa3); }
}

template <int DVB, bool HASKR, bool BIAS, int SD, bool FIX, bool CINIT>
__device__ __forceinline__ void attn_pass(const bf16* __restrict__ Qrow, const bf16* __restrict__ Kn, int ldk, const bf16* __restrict__ Kr,
                                          const bf16* __restrict__ Vh, int ldv, const int* __restrict__ posk, float pq, float cneg, char* lds, f32x16 (&o)[DVB], const int tid, const int t0, const int NT, const float negref) {
    constexpr int DQB = HASKR ? 6 : 4;
    const int wid = tid >> 6, lane = tid & 63, r32 = lane & 31, hi = lane >> 5;
    float* wsf = (float*)(lds + WSF_OFF) + wid * 64; float* li_l = wsf; float* al_l = wsf + 32;
    float m_reg = -1e30f, l_reg = 0.f;
#pragma unroll
    for (int d = 0; d < DVB; ++d) o[d] = f32x16{};
    bf16x8 qr[DQB];
#pragma unroll
    for (int d0 = 0; d0 < DQB; ++d0) qr[d0] = *reinterpret_cast<const bf16x8*>(Qrow + d0 * 16);
    const int kn_r = tid >> 3, kn_c = (tid & 7) * 8, kn_st = kn_r * 144 + kn_c * 2;
    const int kr_r = (tid >> 2) & 63, kr_c = (tid & 3) * 8, kr_st = kr_r * 80 + kr_c * 2;
    const int v4_r = tid >> 4, v4_c = (tid & 15) * 8;
    const int vst0 = (DVB == 2) ? v_st<DVB>(kn_r, kn_c) : v_st<DVB>(v4_r, v4_c), vst1 = (DVB == 2) ? 0 : v_st<DVB>(32 + v4_r, v4_c);
    const int vb0 = (int)(uintptr_t)(lds + V_OFF) + v_rd_base(lane);
    struct Slot { bf16x8 kn, kr, v0, v1; float pk; } sr_[SD];
#define SLOAD(i, k0) do { sr_[i].kn = *reinterpret_cast<const bf16x8*>(Kn + (size_t)((k0) + kn_r) * ldk + kn_c); \
    if constexpr (HASKR) sr_[i].kr = *reinterpret_cast<const bf16x8*>(Kr + (size_t)((k0) + kr_r) * 32 + kr_c); \
    if constexpr (DVB == 2) sr_[i].v0 = *reinterpret_cast<const bf16x8*>(Vh + (size_t)((k0) + kn_r) * ldv + kn_c); \
    else { sr_[i].v0 = *reinterpret_cast<const bf16x8*>(Vh + (size_t)((k0) + v4_r) * ldv + v4_c); sr_[i].v1 = *reinterpret_cast<const bf16x8*>(Vh + (size_t)((k0) + 32 + v4_r) * ldv + v4_c); } \
    if constexpr (BIAS) sr_[i].pk = (float)posk[(k0) + (tid & 63)]; } while (0)
#define SWRITE(boff, i) do { char* bb_ = lds + (boff); *reinterpret_cast<bf16x8*>(bb_ + KN_OFF + kn_st) = sr_[i].kn; \
    if constexpr (HASKR) { if (tid < 256) *reinterpret_cast<bf16x8*>(bb_ + KR_OFF + kr_st) = sr_[i].kr; } \
    *reinterpret_cast<bf16x8*>(bb_ + V_OFF + vst0) = sr_[i].v0; \
    if constexpr (DVB == 4) *reinterpret_cast<bf16x8*>(bb_ + V_OFF + vst1) = sr_[i].v1; \
    if constexpr (BIAS) { if (tid < 64) *reinterpret_cast<float*>(bb_ + PK_OFF + tid * 4) = sr_[i].pk; } } while (0)
#define RESC(a) do { if (__any((a) < 1.f)) { if (hi == 0) al_l[r32] = (a); asm volatile("s_waitcnt lgkmcnt(0)" ::: "memory"); \
    _Pragma("unroll") for (int d = 0; d < DVB; ++d) _Pragma("unroll") for (int r = 0; r < 16; ++r) o[d][r] *= al_l[crow(r, hi)]; } } while (0)
    f32x16 pA0, pA1, pB0, pB1; float alA = 1.f, alB = 1.f; bf16x8 pa0, pa1, pa2, pa3;
    f32x16 cinit = f32x16{};
    if constexpr (FIX && CINIT) {
#pragma unroll
        for (int r = 0; r < 16; ++r) cinit[r] = negref;
        asm volatile("" : "+v"(cinit));
    }
#define SMP(P0, P1, AL, BUFP) do { if constexpr (FIX) partialSM_fix<BIAS, !CINIT>(P0, P1, (BUFP) + PK_OFF, hi, pq, cneg, negref); else partialSM<BIAS>(P0, P1, m_reg, AL, (BUFP) + PK_OFF, hi, pq, cneg); } while (0)
#define SMF(P0, P1, AL) do { if constexpr (FIX) finishSM_fix(P0, P1, l_reg, pa0, pa1, pa2, pa3); else finishSM(P0, P1, AL, l_reg, pa0, pa1, pa2, pa3); } while (0)
#define RESCX(AL) do { if constexpr (!FIX) RESC(AL); } while (0)
    int oV = 0, oK = BUF, oW = 2 * BUF;
#define ROT() do { const int t_ = oV; oV = oK; oK = oW; oW = t_; } while (0)
#define ITER(PX0, PX1, ALX, PY0, PY1, ALY, i, PAR) do { \
        SBAR(); qkt<HASKR>(PY0, PY1, lds + oK, qr, r32, hi, cinit); SMF(PX0, PX1, ALX); SBAR(); \
        if constexpr (SD == 2) { if ((i) + 3 < NT) SLOAD(1 - (PAR), (t0 + (i) + 3) * 64); } else { if ((i) + 2 < NT) SLOAD(0, (t0 + (i) + 2) * 64); } SBAR(); \
        pv_all<DVB>(o, vb0 + oV, pa0, pa1, pa2, pa3); SMP(PY0, PY1, ALY, lds + oK); RESCX(ALY); \
        if ((i) + 2 < NT) SWRITE(oW, (SD == 2) ? (PAR) : 0); \
        __syncthreads(); ROT(); } while (0)
    SLOAD(0, t0 * 64); SWRITE(0, 0);
    SLOAD(SD - 1, (t0 + 1) * 64); SWRITE(BUF, SD - 1);
    if constexpr (SD == 2) if (2 < NT) SLOAD(0, (t0 + 2) * 64);
    __syncthreads();
    qkt<HASKR>(pA0, pA1, lds, qr, r32, hi, cinit); SMP(pA0, pA1, alA, lds); RESCX(alA);
    for (int i = 0; i + 2 < NT; i += 2) {
        ITER(pA0, pA1, alA, pB0, pB1, alB, i, 0);
        ITER(pB0, pB1, alB, pA0, pA1, alA, i + 1, 1);
    }
    ITER(pA0, pA1, alA, pB0, pB1, alB, NT - 2, 0);
    SMF(pB0, pB1, alB); SBAR();
    pv_all<DVB>(o, vb0 + oV, pa0, pa1, pa2, pa3);
#undef ITER
#undef ROT
    if constexpr (FIX) l_reg = add_xor32(l_reg);
    if (hi == 0) li_l[r32] = l_reg; asm volatile("s_waitcnt lgkmcnt(0)" ::: "memory");
#pragma unroll
    for (int r = 0; r < 16; ++r) { const float rl = __builtin_amdgcn_rcpf(li_l[crow(r, hi)]);
#pragma unroll
        for (int d = 0; d < DVB; ++d) o[d][r] *= rl; }
    __syncthreads();
#undef SLOAD
#undef SWRITE
#undef RESC
#undef SMP
#undef SMF
#undef RESCX
}

__device__ __forceinline__ void attn_mla2(const bf16* __restrict__ Q0, const bf16* __restrict__ Q1, const bf16* __restrict__ Kn, const bf16* __restrict__ Kr, const bf16* __restrict__ Vh,
                                          char* lds, f32x16 (&o)[2][2], const int tid, const float nr0, const float nr1) {
    const int wid = tid >> 6, lane = tid & 63, r32 = lane & 31, hi = lane >> 5;
    float* wsf = (float*)(lds + WSF_OFF) + wid * 64;
    float l0 = 0.f, l1 = 0.f;
#pragma unroll
    for (int rb = 0; rb < 2; ++rb)
#pragma unroll
        for (int d = 0; d < 2; ++d) o[rb][d] = f32x16{};
    bf16x8 q0[6], q1[6];
#pragma unroll
    for (int d0 = 0; d0 < 6; ++d0) { q0[d0] = *reinterpret_cast<const bf16x8*>(Q0 + d0 * 16); q1[d0] = *reinterpret_cast<const bf16x8*>(Q1 + d0 * 16); }
    const int kn_r = tid >> 3, kn_c = (tid & 7) * 8, kn_st = kn_r * 144 + kn_c * 2;
    const int kr_r = (tid >> 2) & 63, kr_c = (tid & 3) * 8, kr_st = kr_r * 80 + kr_c * 2;
    const int vst0 = v_st<2>(kn_r, kn_c);
    const int vb0 = (int)(uintptr_t)(lds + V_OFF) + v_rd_base(lane);
    bf16x8 s_kn, s_kr, s_v;
#define SLOAD2(k0) do { s_kn = *reinterpret_cast<const bf16x8*>(Kn + (size_t)((k0) + kn_r) * 1024 + kn_c); s_kr = *reinterpret_cast<const bf16x8*>(Kr + (size_t)((k0) + kr_r) * 32 + kr_c); \
    s_v = *reinterpret_cast<const bf16x8*>(Vh + (size_t)((k0) + kn_r) * 1024 + kn_c); } while (0)
#define SWRITE2(boff) do { char* bb_ = lds + (boff); *reinterpret_cast<bf16x8*>(bb_ + KN_OFF + kn_st) = s_kn; if (tid < 256) *reinterpret_cast<bf16x8*>(bb_ + KR_OFF + kr_st) = s_kr; \
    *reinterpret_cast<bf16x8*>(bb_ + V_OFF + vst0) = s_v; } while (0)
#define PK4(P, BASE, OUT) do { unsigned a0 = cvtpk(P[BASE + 0], P[BASE + 1]), a1 = cvtpk(P[BASE + 2], P[BASE + 3]);   \
    unsigned b0 = cvtpk(P[BASE + 4], P[BASE + 5]), b1 = cvtpk(P[BASE + 6], P[BASE + 7]);                              \
    auto r0 = __builtin_amdgcn_permlane32_swap(a0, b0, false, false); auto r1 = __builtin_amdgcn_permlane32_swap(a1, b1, false, false); \
    u32x4 w = {r0[0], r1[0], r0[1], r1[1]}; OUT = *reinterpret_cast<bf16x8*>(&w); } while (0)
    constexpr int NT = SEQ / 64;
    SLOAD2(0); SWRITE2(0); __syncthreads();
    int cur = 0;
    for (int t = 0; t < NT; ++t) {
        const char* buf = lds + cur;
        f32x16 pa0 = f32x16{}, pa1 = f32x16{}, pb0 = f32x16{}, pb1 = f32x16{};
        {
            const char* kb = buf + KN_OFF + r32 * 144 + hi * 16; const char* kr = buf + KR_OFF + r32 * 80 + hi * 16;
#define KLD0(D0) ((D0) < 4 ? *reinterpret_cast<const bf16x8*>(kb + (D0) * 32) : *reinterpret_cast<const bf16x8*>(kr + ((D0) - 4) * 32))
#define KLD1(D0) ((D0) < 4 ? *reinterpret_cast<const bf16x8*>(kb + 32 * 144 + (D0) * 32) : *reinterpret_cast<const bf16x8*>(kr + 32 * 80 + ((D0) - 4) * 32))
            bf16x8 c0 = KLD0(0), c1 = KLD1(0);
            __builtin_amdgcn_s_setprio(1);
#pragma unroll
            for (int d0 = 0; d0 < 6; ++d0) {
                bf16x8 n0 = c0, n1 = c1;
                if (d0 + 1 < 6) { n0 = KLD0(d0 + 1); n1 = KLD1(d0 + 1); }
                pa0 = __builtin_amdgcn_mfma_f32_32x32x16_bf16(c0, q0[d0], pa0, 0, 0, 0); pb0 = __builtin_amdgcn_mfma_f32_32x32x16_bf16(c0, q1[d0], pb0, 0, 0, 0);
                pa1 = __builtin_amdgcn_mfma_f32_32x32x16_bf16(c1, q0[d0], pa1, 0, 0, 0); pb1 = __builtin_amdgcn_mfma_f32_32x32x16_bf16(c1, q1[d0], pb1, 0, 0, 0);
                SBAR(); c0 = n0; c1 = n1;
            }
            __builtin_amdgcn_s_setprio(0);
#undef KLD0
#undef KLD1
        }
        if (t + 1 < NT) SLOAD2((t + 1) * 64);
        bf16x8 fa0, fa1, fa2, fa3, fb0, fb1, fb2, fb3;
        {   float ps = 0.f;
#pragma unroll
            for (int r = 0; r < 16; ++r) { pa0[r] = __builtin_amdgcn_exp2f(pa0[r]); pa1[r] = __builtin_amdgcn_exp2f(pa1[r]);     ps += pa0[r] + pa1[r]; }
            l0 += ps; PK4(pa0, 0, fa0); PK4(pa0, 8, fa1); PK4(pa1, 0, fa2); PK4(pa1, 8, fa3); }
        {   float ps = 0.f;
#pragma unroll
            for (int r = 0; r < 16; ++r) { pb0[r] = __builtin_amdgcn_exp2f(pb0[r]); pb1[r] = __builtin_amdgcn_exp2f(pb1[r]); ps += pb0[r] + pb1[r]; }
            l1 += ps; PK4(pb0, 0, fb0); PK4(pb0, 8, fb1); PK4(pb1, 0, fb2); PK4(pb1, 8, fb3); }
        {   const int vb = vb0 + cur;
#define PV2(D0) do { constexpr int KS = 2 * 2 * 512, HF = 2 * 512, B0 = (D0) * 512; \
            const s16x4 l0_ = tr_read<B0>(vb), h0_ = tr_read<B0 + HF>(vb), l1_ = tr_read<B0 + KS>(vb), h1_ = tr_read<B0 + KS + HF>(vb); \
            const s16x4 l2_ = tr_read<B0 + 2 * KS>(vb), h2_ = tr_read<B0 + 2 * KS + HF>(vb), l3_ = tr_read<B0 + 3 * KS>(vb), h3_ = tr_read<B0 + 3 * KS + HF>(vb); \
            asm volatile("s_waitcnt lgkmcnt(0)" ::: "memory"); SBAR(); \
            const bf16x8 v0_ = (bf16x8){l0_[0], l0_[1], l0_[2], l0_[3], h0_[0], h0_[1], h0_[2], h0_[3]}, v1_ = (bf16x8){l1_[0], l1_[1], l1_[2], l1_[3], h1_[0], h1_[1], h1_[2], h1_[3]}; \
            const bf16x8 v2_ = (bf16x8){l2_[0], l2_[1], l2_[2], l2_[3], h2_[0], h2_[1], h2_[2], h2_[3]}, v3_ = (bf16x8){l3_[0], l3_[1], l3_[2], l3_[3], h3_[0], h3_[1], h3_[2], h3_[3]}; \
            o[0][D0] = __builtin_amdgcn_mfma_f32_32x32x16_bf16(fa0, v0_, o[0][D0], 0, 0, 0); o[1][D0] = __builtin_amdgcn_mfma_f32_32x32x16_bf16(fb0, v0_, o[1][D0], 0, 0, 0); \
            o[0][D0] = __builtin_amdgcn_mfma_f32_32x32x16_bf16(fa1, v1_, o[0][D0], 0, 0, 0); o[1][D0] = __builtin_amdgcn_mfma_f32_32x32x16_bf16(fb1, v1_, o[1][D0], 0, 0, 0); \
            o[0][D0] = __builtin_amdgcn_mfma_f32_32x32x16_bf16(fa2, v2_, o[0][D0], 0, 0, 0); o[1][D0] = __builtin_amdgcn_mfma_f32_32x32x16_bf16(fb2, v2_, o[1][D0], 0, 0, 0); \
            o[0][D0] = __builtin_amdgcn_mfma_f32_32x32x16_bf16(fa3, v3_, o[0][D0], 0, 0, 0); o[1][D0] = __builtin_amdgcn_mfma_f32_32x32x16_bf16(fb3, v3_, o[1][D0], 0, 0, 0); } while (0)
            __builtin_amdgcn_s_setprio(1); PV2(0); PV2(1); __builtin_amdgcn_s_setprio(0);
#undef PV2
        }
        if (t + 1 < NT) {
            int tw = tid; asm volatile("" : "+v"(tw));
            char* bb_ = lds + (BUF - cur);
            *reinterpret_cast<bf16x8*>(bb_ + KN_OFF + (tw >> 3) * 144 + (tw & 7) * 16) = s_kn;
            if (tw < 256) *reinterpret_cast<bf16x8*>(bb_ + KR_OFF + ((tw >> 2) & 63) * 80 + (tw & 3) * 16) = s_kr;
            *reinterpret_cast<bf16x8*>(bb_ + V_OFF + v_st<2>(tw >> 3, (tw & 7) * 8)) = s_v;
        }
        __syncthreads();
        cur = BUF - cur;
    }
    l0 = add_xor32(l0); l1 = add_xor32(l1);
    if (hi == 0) { wsf[r32] = l0; wsf[32 + r32] = l1; } asm volatile("s_waitcnt lgkmcnt(0)" ::: "memory");
#pragma unroll
    for (int r = 0; r < 16; ++r) { const float ra = __builtin_amdgcn_rcpf(wsf[crow(r, hi)]), rb = __builtin_amdgcn_rcpf(wsf[32 + crow(r, hi)]);
#pragma unroll
        for (int d = 0; d < 2; ++d) { o[0][d][r] *= ra; o[1][d][r] *= rb; } }
    __syncthreads();
#undef SLOAD2
#undef SWRITE2
#undef PK4
}
__device__ __forceinline__ void attn_diff1(const bf16* __restrict__ Qrow, const bf16* __restrict__ Kn, const bf16* __restrict__ Vh, const int* __restrict__ posk, const float pq, const float cneg,
                                           char* lds, f32x16 (&o)[4], const int tid, const int t0, const int NT, const float negref) {
    const int wid = tid >> 6, lane = tid & 63, r32 = lane & 31, hi = lane >> 5;
    float* wsf = (float*)(lds + WSF_OFF) + wid * 64;
    float l_reg = 0.f;
#pragma unroll
    for (int d = 0; d < 4; ++d) o[d] = f32x16{};
    bf16x8 qr[4];
#pragma unroll
    for (int d0 = 0; d0 < 4; ++d0) qr[d0] = *reinterpret_cast<const bf16x8*>(Qrow + d0 * 16);
    const int kn_r = tid >> 3, kn_c = (tid & 7) * 8, kn_st = kn_r * 144 + kn_c * 2;
    const int v4_r = tid >> 4, v4_c = (tid & 15) * 8;
    const int vst0 = v_st<4>(v4_r, v4_c), vst1 = v_st<4>(32 + v4_r, v4_c);
    const int vb0 = (int)(uintptr_t)(lds + V_OFF) + v_rd_base(lane);
    bf16x8 s_kn, s_v0, s_v1; float s_pk;
#define SLOADD(k0) do { s_kn = *reinterpret_cast<const bf16x8*>(Kn + (size_t)((k0) + kn_r) * 1024 + kn_c); s_v0 = *reinterpret_cast<const bf16x8*>(Vh + (size_t)((k0) + v4_r) * 1024 + v4_c); \
    s_v1 = *reinterpret_cast<const bf16x8*>(Vh + (size_t)((k0) + 32 + v4_r) * 1024 + v4_c); s_pk = (float)posk[(k0) + (tid & 63)]; } while (0)
#define SWRITED(boff) do { char* bb_ = lds + (boff); *reinterpret_cast<bf16x8*>(bb_ + KN_OFF + kn_st) = s_kn; *reinterpret_cast<bf16x8*>(bb_ + V_OFF + vst0) = s_v0; \
    *reinterpret_cast<bf16x8*>(bb_ + V_OFF + vst1) = s_v1; if (tid < 64) *reinterpret_cast<float*>(bb_ + PK_OFF + tid * 4) = s_pk; } while (0)
#define PK4(P, BASE, OUT) do { unsigned a0 = cvtpk(P[BASE + 0], P[BASE + 1]), a1 = cvtpk(P[BASE + 2], P[BASE + 3]);   \
    unsigned b0 = cvtpk(P[BASE + 4], P[BASE + 5]), b1 = cvtpk(P[BASE + 6], P[BASE + 7]);                              \
    auto r0 = __builtin_amdgcn_permlane32_swap(a0, b0, false, false); auto r1 = __builtin_amdgcn_permlane32_swap(a1, b1, false, false); \
    u32x4 w = {r0[0], r1[0], r0[1], r1[1]}; OUT = *reinterpret_cast<bf16x8*>(&w); } while (0)
    SLOADD(t0 * 64); SWRITED(0); __syncthreads();
    int cur = 0;
    for (int t = 0; t < NT; ++t) {
        const char* buf = lds + cur;
        f32x16 p0 = f32x16{}, p1 = f32x16{};
        {   const char* kb = buf + KN_OFF + r32 * 144 + hi * 16;
            bf16x8 c0 = *reinterpret_cast<const bf16x8*>(kb), c1 = *reinterpret_cast<const bf16x8*>(kb + 32 * 144);
            __builtin_amdgcn_s_setprio(1);
#pragma unroll
            for (int d0 = 0; d0 < 4; ++d0) {
                bf16x8 n0 = c0, n1 = c1;
                if (d0 + 1 < 4) { n0 = *reinterpret_cast<const bf16x8*>(kb + (d0 + 1) * 32); n1 = *reinterpret_cast<const bf16x8*>(kb + 32 * 144 + (d0 + 1) * 32); }
                p0 = __builtin_amdgcn_mfma_f32_32x32x16_bf16(c0, qr[d0], p0, 0, 0, 0); p1 = __builtin_amdgcn_mfma_f32_32x32x16_bf16(c1, qr[d0], p1, 0, 0, 0);
                c0 = n0; c1 = n1;
            }
            __builtin_amdgcn_s_setprio(0);
        }
        if (t + 1 < NT) SLOADD((t0 + t + 1) * 64);
        const int vb = vb0 + cur;
#define VRD(D0, L, H) do { constexpr int KS = 2 * 4 * 512, HF = 4 * 512, B0 = (D0) * 512; \
            L[0] = tr_read<B0>(vb); H[0] = tr_read<B0 + HF>(vb); L[1] = tr_read<B0 + KS>(vb); H[1] = tr_read<B0 + KS + HF>(vb); \
            L[2] = tr_read<B0 + 2 * KS>(vb); H[2] = tr_read<B0 + 2 * KS + HF>(vb); L[3] = tr_read<B0 + 3 * KS>(vb); H[3] = tr_read<B0 + 3 * KS + HF>(vb); } while (0)
#define VFR(L, H, k) (bf16x8){L[k][0], L[k][1], L[k][2], L[k][3], H[k][0], H[k][1], H[k][2], H[k][3]}
#define PVM(D0, L, H) do { o[D0] = __builtin_amdgcn_mfma_f32_32x32x16_bf16(fa0, VFR(L, H, 0), o[D0], 0, 0, 0); o[D0] = __builtin_amdgcn_mfma_f32_32x32x16_bf16(fa1, VFR(L, H, 1), o[D0], 0, 0, 0); \
            o[D0] = __builtin_amdgcn_mfma_f32_32x32x16_bf16(fa2, VFR(L, H, 2), o[D0], 0, 0, 0); o[D0] = __builtin_amdgcn_mfma_f32_32x32x16_bf16(fa3, VFR(L, H, 3), o[D0], 0, 0, 0); } while (0)
        s16x4 la[4], ha[4], lb[4], hb[4];
        VRD(0, la, ha); VRD(1, lb, hb);
        {   const char* pkl = buf + PK_OFF;
#pragma unroll
            for (int i = 0; i < 4; ++i) {
                const f32x4 k0 = *(const f32x4*)(pkl + (8 * i + 4 * hi) * 4), k1 = *(const f32x4*)(pkl + (32 + 8 * i + 4 * hi) * 4);
#pragma unroll
                for (int q = 0; q < 4; ++q) { p0[4 * i + q] = fmaf(fabsf(pq - k0[q]), cneg, p0[4 * i + q]); p1[4 * i + q] = fmaf(fabsf(pq - k1[q]), cneg, p1[4 * i + q]); }
            }
        }
        bf16x8 fa0, fa1, fa2, fa3;
        {   float ps = 0.f;
#pragma unroll
            for (int r = 0; r < 16; ++r) { p0[r] = __builtin_amdgcn_exp2f(p0[r]); p1[r] = __builtin_amdgcn_exp2f(p1[r]);     ps += p0[r] + p1[r]; }
            l_reg += ps; PK4(p0, 0, fa0); PK4(p0, 8, fa1); PK4(p1, 0, fa2); PK4(p1, 8, fa3); }
        asm volatile("s_waitcnt lgkmcnt(0)" ::: "memory"); SBAR();
        __builtin_amdgcn_s_setprio(1);
        PVM(0, la, ha); SBAR();
        VRD(2, la, ha);
        SBAR(); PVM(1, lb, hb); SBAR();
        VRD(3, lb, hb);
        asm volatile("s_waitcnt lgkmcnt(8)" ::: "memory"); SBAR();
        PVM(2, la, ha);
        asm volatile("s_waitcnt lgkmcnt(0)" ::: "memory"); SBAR();
        PVM(3, lb, hb);
        __builtin_amdgcn_s_setprio(0);
#undef VRD
#undef VFR
#undef PVM
        if (t + 1 < NT) SWRITED(BUF - cur);
        __syncthreads();
        cur = BUF - cur;
    }
    l_reg = add_xor32(l_reg);
    if (hi == 0) wsf[r32] = l_reg; asm volatile("s_waitcnt lgkmcnt(0)" ::: "memory");
#pragma unroll
    for (int r = 0; r < 16; ++r) { const float rl = __builtin_amdgcn_rcpf(wsf[crow(r, hi)]);
#pragma unroll
        for (int d = 0; d < 4; ++d) o[d][r] *= rl; }
    __syncthreads();
#undef SLOADD
#undef SWRITED
#undef PK4
}
}

#define XB_TMO      128
#define XB_XCNT(j)  (256  + 64 * (j))
#define XB_XSUB(j)  (1280 + 64 * (j))
#define XB_XGEN(j)  (2304 + 64 * (j))
#define XB_TOP      3328
#define XB_TOPGEN   3392
#define XCD_BAR_WORDS 3456
#define XB_SPIN_CAP (1u << 18)

__device__ __forceinline__ unsigned xb_ld(unsigned* p)              { return __hip_atomic_load(p, __ATOMIC_RELAXED, __HIP_MEMORY_SCOPE_AGENT); }
__device__ __forceinline__ unsigned xb_add(unsigned* p, unsigned v) { return __hip_atomic_fetch_add(p, v, __ATOMIC_RELAXED, __HIP_MEMORY_SCOPE_AGENT); }
__device__ __forceinline__ unsigned xb_xcc_id() { return (unsigned)__builtin_amdgcn_s_getreg((3 << 11) | 20) & 0xFu; }
#define XB_SPIN(cond, bar) do { unsigned _sp = 0; while (cond) { __builtin_amdgcn_s_sleep(1); \
    if ((++_sp & 255u) == 0u) { if (xb_ld(&(bar)[XB_TMO])) break; if (_sp > XB_SPIN_CAP) { atomicAdd(&(bar)[XB_TMO], 1u); break; } } } } while (0)

struct XcdBarrier {
    unsigned* bar; unsigned x;
    volatile LAS unsigned* st;
};

__device__ __forceinline__ XcdBarrier xcd_barrier_post(unsigned* bar, volatile LAS unsigned* st) {
    XcdBarrier b; b.bar = bar; b.x = xb_xcc_id(); b.st = st;
    if (threadIdx.x == 0) (void)xb_add(&bar[XB_XCNT(b.x)], 1u);
    return b;
}
__device__ __forceinline__ void xcd_barrier_complete(unsigned* bar, unsigned x, unsigned& nloc, unsigned& nx) {
    const unsigned G = gridDim.x * gridDim.y * gridDim.z;
    unsigned sum, cnt, mine, sp = 0u;
    for (;;) {
        sum = 0u; cnt = 0u; mine = 0u;
#pragma unroll
        for (unsigned j = 0; j < 16; ++j) { const unsigned c = xb_ld(&bar[XB_XCNT(j)]); sum += c; cnt += (c > 0u) ? 1u : 0u; mine = (j == x) ? c : mine; }
        if (sum == G) break;
        __builtin_amdgcn_s_sleep(1);
        if ((++sp & 255u) == 0u) { if (xb_ld(&bar[XB_TMO])) break; if (sp > XB_SPIN_CAP) { atomicAdd(&bar[XB_TMO], 1u); break; } }
    }
    nloc = mine > 0u ? mine : 1u; nx = cnt > 0u ? cnt : 1u;
}

__device__ __forceinline__ void xcd_barrier(const XcdBarrier& b) {
    asm volatile("s_waitcnt vmcnt(0)" ::: "memory");
    __syncthreads();
    if (threadIdx.x == 0) {
        unsigned* bar = b.bar;
        __builtin_amdgcn_s_waitcnt(0);
        unsigned nloc = b.st[0], nx = b.st[1];
        if (nloc == 0u) { xcd_barrier_complete(bar, b.x, nloc, nx); b.st[0] = nloc; b.st[1] = nx; }
        const unsigned old = xb_add(&bar[XB_XSUB(b.x)], 1u);
        const unsigned gen = old / nloc;
        if (old + 1u == (gen + 1u) * nloc) {
            __builtin_amdgcn_fence(__ATOMIC_RELEASE, "agent");
            asm volatile("s_waitcnt vmcnt(0)" ::: "memory");
            const unsigned og = xb_add(&bar[XB_TOP], 1u);
            const unsigned tg = og / nx;
            if (og + 1u == (tg + 1u) * nx) xb_add(&bar[XB_TOPGEN], 1u);
            else XB_SPIN(xb_ld(&bar[XB_TOPGEN]) == tg, bar);
            __builtin_amdgcn_fence(__ATOMIC_ACQUIRE, "agent");
            xb_add(&bar[XB_XGEN(b.x)], 1u);
            asm volatile("s_waitcnt vmcnt(0)" ::: "memory");
        } else {
            XB_SPIN(xb_ld(&bar[XB_XGEN(b.x)]) == gen, bar);
            __builtin_amdgcn_fence(__ATOMIC_ACQUIRE, "agent");
            asm volatile("s_waitcnt vmcnt(0)" ::: "memory");
        }
    }
    __syncthreads();
}

struct Args {
    const float* x; const float* c; const int* pos; const float* ada_w; const float* ada_b; const float* norm_g;
    const float* mla_w_in; const float* mla_qg; const float* mla_wq; const float* mla_kvg; const float* mla_wkv; const float* mla_wo;
    const float* diff_w_in; const float* lq1; const float* lk1; const float* lq2; const float* lk2; const float* head_g; const float* diff_wo; const float* final_g;
    float* out; unsigned char* ws;
};

__device__ __forceinline__ unsigned f2bf(float f) { unsigned u = __builtin_bit_cast(unsigned, f); return (u + 0x7fffu + ((u >> 16) & 1u)) >> 16; }
__device__ __forceinline__ unsigned pk2(float lo, float hi) { return f2bf(lo) | (f2bf(hi) << 16); }

__device__ __forceinline__ void transpose_item(const float* W, const float* gain, int K, int N, bf16* WT, LAS float* scr, int item, int lane) {
    const int nblk = N / 32, kb = item / nblk, nb = item % nblk, k0 = 64 * kb, n0 = 32 * nb;
    f32x4 wv[8];
#pragma unroll
    for (int i = 0; i < 8; ++i) wv[i] = *(const f32x4*)(W + (size_t)(k0 + 8 * i + (lane >> 3)) * N + n0 + (lane & 7) * 4);
#pragma unroll
    for (int i = 0; i < 8; ++i) { const int kk = 8 * i + (lane >> 3); f32x4 w = wv[i]; if (gain) w = w * gain[k0 + kk]; LAS float* d = scr + kk * 33 + (lane & 7) * 4; d[0] = w[0]; d[1] = w[1]; d[2] = w[2]; d[3] = w[3]; }
    asm volatile("s_waitcnt lgkmcnt(0)" ::: "memory");
    const int c = lane & 7;
#pragma unroll
    for (int j = 0; j < 4; ++j) { const int n = (lane >> 3) + 8 * j; const LAS float* s = scr + (8 * c) * 33 + n;
        u32x4 o; o.x = pk2(s[0 * 33], s[1 * 33]); o.y = pk2(s[2 * 33], s[3 * 33]); o.z = pk2(s[4 * 33], s[5 * 33]); o.w = pk2(s[6 * 33], s[7 * 33]);
        *(u32x4*)(WT + (size_t)(n0 + n) * K + k0 + 8 * c) = o; }
    asm volatile("s_waitcnt lgkmcnt(0)" ::: "memory");
}

template <class F>
__device__ __forceinline__ void run_gemm(LAS unsigned char* lds, const bf16* A, int lda, const bf16* Bt, int N, int K, const F& f, const int tid, const int bxp, const int Gp) {
    pg8::Gemm g{A, Bt, M, N, K, lda}; pg8::StaticOrder S; S.init(M, N, Gp, bxp);
    pg8::EpiF<F> E{f};
    pg8::gemm_phase<pg8::EpiF<F>, pg8::StaticOrder, true, true>(lds, g, S, E, tid);
}

typedef const __attribute__((address_space(4))) Args KArgs;
__global__ void __launch_bounds__(512, 2) fwd_kernel(Args a) {
    extern __shared__ __attribute__((aligned(16))) unsigned char lds[];
    cg::grid_group grid = cg::this_grid();
    LAS unsigned char* ldsl = (LAS unsigned char*)lds;
    volatile LAS unsigned* bar_st = (volatile LAS unsigned*)(ldsl + 131072 + 64);
    if (threadIdx.x == 0) { bar_st[0] = 0u; bar_st[1] = 0u; }
    __syncthreads();
    const int tid = threadIdx.x, lane = tid & 63, wave = __builtin_amdgcn_readfirstlane(tid >> 6);
    const int G = gridDim.x, bx = blockIdx.x;
    const int vcu = (G % 8 == 0) ? (bx % 8) * (G / 8) + bx / 8 : bx;
    const int gw = bx * 8 + wave, ngw = G * 8;
    unsigned char* ws = a.ws;
    float* MOD = (float*)(ws + WS_MOD); float* PAR = (float*)(ws + WS_PAR); float* SSQ = (float*)(ws + WS_SSQ);
    float* RC = (float*)(ws + WS_COS); float* RS = (float*)(ws + WS_SIN);

    if (bx < 192) {
        float* cact = (float*)lds; float* red = (float*)lds + 2048;
        for (int i = tid; i < 2048; i += 512) cact[i] = silu1(a.c[i]);
        __syncthreads();
        const int l = bx / 48, cgp = bx % 48, col = tid & 63, kg = tid >> 6;
        const float* wp = a.ada_w + (size_t)l * 1024 * 3072 + (size_t)(kg * 128) * 3072 + cgp * 64 + col;
        float acc0 = 0.f, acc1 = 0.f;
#pragma unroll 16
        for (int k = 0; k < 128; ++k) { const float w = wp[(size_t)k * 3072]; acc0 = fmaf(cact[kg * 128 + k], w, acc0); acc1 = fmaf(cact[1024 + kg * 128 + k], w, acc1); }
        red[(kg * 2 + 0) * 64 + col] = acc0; red[(kg * 2 + 1) * 64 + col] = acc1;
        __syncthreads();
        if (tid < 128) { const int b = tid >> 6; float s = 0.f;
#pragma unroll
            for (int q = 0; q < 8; ++q) s += red[(q * 2 + b) * 64 + col];
            MOD[(l * 2 + b) * 3072 + cgp * 64 + col] = s + a.ada_b[l * 3072 + cgp * 64 + col]; }
        __syncthreads();
    }
    {
        LAS float* scr = (LAS float*)(ldsl + wave * 8448);
        constexpr int I_MIN = 16 * 53, I_MQ = 6 * 48, I_MKV = 4 * 64, I_O = 16 * 32, I_DIN = 16 * 128;
        constexpr int PER_J = I_MIN + I_MQ + I_MKV + I_O + I_DIN + I_O, NITEMS = 2 * PER_J;
        for (int it = gw; it < NITEMS; it += ngw) {
            const int j = it / PER_J; int r = it % PER_J;
            unsigned char* wm = ws + WS_WMLA + (size_t)j * W_MLA_SZ; unsigned char* wd = ws + WS_WDIFF + (size_t)j * W_DIFF_SZ;
            if (r < I_MIN) { transpose_item(a.mla_w_in + (size_t)j * 1024 * MLA_IN, nullptr, 1024, MLA_IN, (bf16*)(wm + W_MLA_IN), scr, r, lane); continue; } r -= I_MIN;
            if (r < I_MQ) { transpose_item(a.mla_wq + (size_t)j * 384 * 1536, a.mla_qg + j * 384, 384, 1536, (bf16*)(wm + W_MLA_Q), scr, r, lane); continue; } r -= I_MQ;
            if (r < I_MKV) { transpose_item(a.mla_wkv + (size_t)j * 256 * 2048, a.mla_kvg + j * 256, 256, 2048, (bf16*)(wm + W_MLA_KV), scr, r, lane); continue; } r -= I_MKV;
            if (r < I_O) { transpose_item(a.mla_wo + (size_t)j * 1024 * 1024, nullptr, 1024, 1024, (bf16*)(wm + W_MLA_O), scr, r, lane); continue; } r -= I_O;
            if (r < I_DIN) { transpose_item(a.diff_w_in + (size_t)j * 1024 * 4096, nullptr, 1024, 4096, (bf16*)(wd + W_DIFF_IN), scr, r, lane); continue; } r -= I_DIN;
            transpose_item(a.diff_wo + (size_t)j * 1024 * 1024, nullptr, 1024, 1024, (bf16*)(wd + W_DIFF_O), scr, r, lane);
        }
    }
    {
        const int gt = bx * 512 + tid, ngt = G * 512;
        for (int i = gt; i < M * 16; i += ngt) {
            const int row = i >> 4, fi = i & 15;
            const float inv = (float)exp2(-(double)(2 * fi) / 32.0 * 13.287712379549449);
            const float ang = (float)a.pos[row] * inv;
            const double x = (double)ang; const double n = rint(x * 0.15915494309189535); const double rr = x - n * 6.283185307179586; const double r2 = rr * rr;
            double s = 1.0, c = 1.0;
#pragma unroll
            for (int k = 12; k >= 1; --k) { s = 1.0 - r2 / (double)((2 * k) * (2 * k + 1)) * s; c = 1.0 - r2 / (double)((2 * k - 1) * (2 * k)) * c; }
            RC[i] = (float)c; RS[i] = (float)(rr * s);
        }
        for (int i = gt; i < 4 * M; i += ngt) SSQ[i] = 0.f;
        for (int i = gt; i < 3456; i += ngt) ((unsigned*)(ws + WS_BAR))[i] = 0u;
        for (int i = gt; i < (int)AUX_ZERO_WORDS; i += ngt) ((unsigned*)(ws + WS_AUX + AUX_KN2))[i] = 0u;
        if (gt < 256) { const int* pp = a.pos + (gt >> 7) * SEQ + (gt & 127) * 64; int mn = pp[0], mx = pp[0];
            for (int k = 1; k < 64; ++k) { const int v = pp[k]; mn = min(mn, v); mx = max(mx, v); }
            ((int*)(ws + WS_AUX + AUX_TMIN))[gt] = mn; ((int*)(ws + WS_AUX + AUX_TMAX))[gt] = mx; }
        for (int i = gt; i < 2 * (MLA_IN_PAD - MLA_IN) * 1024 / 2; i += ngt) {
            const int j = i / ((MLA_IN_PAD - MLA_IN) * 512), w = i % ((MLA_IN_PAD - MLA_IN) * 512);
            ((unsigned*)(ws + WS_WMLA + (size_t)j * W_MLA_SZ + W_MLA_IN + (size_t)MLA_IN * 1024 * 2))[w] = 0u;
        }
        if (gt < 2) { const int j = gt; float s1 = 0.f, s2 = 0.f;
            for (int k = 0; k < 64; ++k) { s1 += a.lq1[j * 64 + k] * a.lk1[j * 64 + k]; s2 += a.lq2[j * 64 + k] * a.lk2[j * 64 + k]; }
            const float li = 0.8f - 0.6f * expf(-0.3f * (float)(2 * j + 1));
            PAR[j] = expf(s1) - expf(s2) + li; PAR[2 + j] = li; }
    }
    grid.sync();
    const XcdBarrier xbar = xcd_barrier_post((unsigned*)(a.ws + WS_BAR), bar_st);

#define PH_BEGIN const size_t oz_ = (size_t)(unsigned)opaque_u32(0u); unsigned char* ws = a.ws + oz_; \
    asm volatile("" : "+v"(tidv)); const int tid = tidv, lane = tid & 63, wave = __builtin_amdgcn_readfirstlane(tid >> 6); (void)lane; (void)wave; (void)ws; \
    const int bxp = opaque_u32(blockIdx.x), Gp = opaque_u32(gridDim.x); (void)bxp; (void)Gp;
    int tidv = threadIdx.x;
    for (int l = 0; l < DEPTH; ++l) {
        const int j = l >> 1;
        {
            PH_BEGIN
            const float* xin = (l == 0) ? (a.x + oz_) : (a.out + oz_); const float* modl = (const float*)(ws + WS_MOD) + l * 6144; bf16* HO = (bf16*)(ws + WS_HO);
            const float* ng = (a.norm_g + oz_) + l * D;
            for (int m = bxp * 8 + wave; m < M; m += Gp * 8) {
                const f32x4* xr = (const f32x4*)(xin + (size_t)m * D) + lane; f32x4 v[4]; float s = 0.f;
#pragma unroll
                for (int q = 0; q < 4; ++q) { v[q] = xr[64 * q]; s += dot4(v[q]); }
                const float r = rsqrtf(wave_sum(s) * (1.0f / D) + EPS);
                const float* md = modl + (m >> 13) * 3072;
#pragma unroll
                for (int q = 0; q < 4; ++q) { const int col = 4 * lane + 256 * q;
                    const f32x4 gg = *(const f32x4*)(ng + col), sh = *(const f32x4*)(md + col), sc = *(const f32x4*)(md + 1024 + col);
                    st4(HO + (size_t)m * D + col, (v[q] * r) * gg * (sc + 1.0f) + sh); }
            }
        }
        xcd_barrier(xbar);
        if ((l & 1) == 0) {
            {   PH_BEGIN
                unsigned char* wm = ws + WS_WMLA + (size_t)j * W_MLA_SZ;
                run_gemm(ldsl, (const bf16*)(ws + WS_HO), 1024, (const bf16*)(wm + W_MLA_IN), MLA_IN_PAD, 1024, E1{ws, j}, tid, bxp, Gp);
            }
            xcd_barrier(xbar);
            {   PH_BEGIN
                unsigned char* wm = ws + WS_WMLA + (size_t)j * W_MLA_SZ;
                run_gemm(ldsl, (const bf16*)(ws + WS_QL), 384, (const bf16*)(wm + W_MLA_Q), 1536, 384, E2{ws, j}, tid, bxp, Gp);
            }
            {   PH_BEGIN
                unsigned char* wm = ws + WS_WMLA + (size_t)j * W_MLA_SZ;
                run_gemm(ldsl, (const bf16*)(ws + WS_KVL), 256, (const bf16*)(wm + W_MLA_KV), 2048, 256, E3{ws, j}, tid, bxp, Gp);
            }
            xcd_barrier(xbar);
            {
                PH_BEGIN
                bf16* HO = (bf16*)(ws + WS_HO); const bf16* Qb = (const bf16*)(ws + WS_Q); const bf16* KR = (const bf16*)(ws + WS_KR);
                const bf16* Kb = (const bf16*)(ws + WS_K); const bf16* Vb = (const bf16*)(ws + WS_V); const bf16* Gb = (const bf16*)(ws + WS_G);
                const int vcup = (Gp % 8 == 0) ? (bxp % 8) * (Gp / 8) + bxp / 8 : bxp;
                for (int u = vcup; u < NB * 16 * 16; u += Gp) {
                    const int bh = u >> 4, qb = u & 15, b = bh >> 4, h = bh & 15;
                    asm volatile("" : "+v"(tidv)); const int tid = tidv, lane = tid & 63;
                    const int r32 = lane & 31, hi = lane >> 5; const size_t row0 = (size_t)b * SEQ + qb * 512 + wave * 64;
                    const bf16* qrow0 = Qb + (row0 + r32) * 1536 + h * 96 + hi * 8; const bf16* qrow1 = qrow0 + 32 * 1536;
                    float qa = 0.f, qc = 0.f;
#pragma unroll
                    for (int d0 = 0; d0 < 6; ++d0) { const att::bf16x8 v = *reinterpret_cast<const att::bf16x8*>(qrow0 + d0 * 16), w = *reinterpret_cast<const att::bf16x8*>(qrow1 + d0 * 16);
#pragma unroll
                        for (int e = 0; e < 8; ++e) { const float f = bf2f((bf16)v[e]), g2 = bf2f((bf16)w[e]); qa = fmaf(f, f, qa); qc = fmaf(g2, g2, qc); } }
                    qa = add_xor32(qa); qc = add_xor32(qc);
                    const unsigned* knm = (const unsigned*)(ws + WS_AUX + AUX_KNM) + (j * 2 + b) * 32 + h * 2; const unsigned* krm = (const unsigned*)(ws + WS_AUX + AUX_KRM) + (j * 2 + b) * 16;
                    const float kmax2 = __uint_as_float(knm[0]) + __uint_as_float(knm[1]) + __uint_as_float(krm[0]);
                    const float bnd0 = 1.02f * sqrtf(qa * kmax2) + 0.01f, bnd1 = 1.02f * sqrtf(qc * kmax2) + 0.01f;
                    volatile int* bigf = (volatile int*)(lds + 98304);
                    __syncthreads(); if (tid == 0) bigf[0] = 0; __syncthreads(); if (fmaxf(bnd0, bnd1) > 60.0f) bigf[0] = 1; __syncthreads();
                    const bf16* Kh = Kb + (size_t)b * SEQ * 1024 + h * 64; const bf16* Vh = Vb + (size_t)b * SEQ * 1024 + h * 64; const bf16* Krb = KR + (size_t)b * SEQ * 32;
                    if (bigf[0] == 0) {
                        att::f32x16 o2[2][2];
                        const bf16* qr0 = qrow0; asm volatile("" : "+v"(qr0));
                        att::attn_mla2(qr0, qr0 + 32 * 1536, Kh, Krb, Vh, (char*)lds, o2, tid, -bnd0, -bnd1);
                        asm volatile("" : "+v"(tidv));
                        const int lane_e = tidv & 63, r32e = lane_e & 31, hie = lane_e >> 5; const size_t row0e = (size_t)b * SEQ + qb * 512 + (size_t)__builtin_amdgcn_readfirstlane(tidv >> 6) * 64;
                        float* stg = (float*)lds + (size_t)__builtin_amdgcn_readfirstlane(tidv >> 6) * (32 * 68);
#pragma unroll
                        for (int rb = 0; rb < 2; ++rb) {
#pragma unroll
                            for (int r = 0; r < 16; ++r)
#pragma unroll
                                for (int d = 0; d < 2; ++d) stg[att::crow(r, hie) * 68 + d * 32 + r32e] = o2[rb][d][r];
                            asm volatile("s_waitcnt lgkmcnt(0)" ::: "memory");
#pragma unroll
                            for (int i = 0; i < 4; ++i) { const int rw = i * 8 + (lane_e >> 3), cc = (lane_e & 7) * 8;
                                const f32x4 v0 = *(const f32x4*)(stg + rw * 68 + cc), v1 = *(const f32x4*)(stg + rw * 68 + cc + 4);
                                const size_t off = (row0e + rb * 32 + rw) * 1024 + h * 64 + cc;
                                const u32x4 g = *(const u32x4*)(Gb + off);
                                const f32x4 g0 = {__uint_as_float(g.x << 16), __uint_as_float(g.x & 0xffff0000u), __uint_as_float(g.y << 16), __uint_as_float(g.y & 0xffff0000u)};
                                const f32x4 g1 = {__uint_as_float(g.z << 16), __uint_as_float(g.z & 0xffff0000u), __uint_as_float(g.w << 16), __uint_as_float(g.w & 0xffff0000u)};
                                st8(HO + off, v0 * g0, v1 * g1); }
                            asm volatile("s_waitcnt lgkmcnt(0)" ::: "memory");
                        }
                    } else {
#pragma unroll 1
                        for (int half = 0; half < 2; ++half) {
                            const size_t rw0 = (size_t)b * SEQ + qb * 512 + half * 256 + wave * 32;
                            att::f32x16 o[2];
                            att::attn_pass<2, true, false, 2, false, false>(Qb + (rw0 + r32) * 1536 + h * 96 + hi * 8, Kh, 1024, Krb, Vh, 1024, nullptr, 0.f, 0.f, (char*)lds, o, tid, 0, SEQ / 64, 0.f);
#pragma unroll
                            for (int r = 0; r < 16; ++r) { const size_t row = rw0 + att::crow(r, hi);
#pragma unroll
                                for (int d = 0; d < 2; ++d) { const size_t off = row * 1024 + h * 64 + d * 32 + r32; HO[off] = (bf16)f2bf(o[d][r] * bf2f(Gb[off])); } }
                        }
                    }
                }
            }
            xcd_barrier(xbar);
            {   PH_BEGIN
                unsigned char* wm = ws + WS_WMLA + (size_t)j * W_MLA_SZ; const float* xin = (l == 0) ? (a.x + oz_) : (a.out + oz_);
                run_gemm(ldsl, (const bf16*)(ws + WS_HO), 1024, (const bf16*)(wm + W_MLA_O), 1024, 1024, E4{ws, xin, (a.out + oz_), l}, tid, bxp, Gp);
            }
            xcd_barrier(xbar);
        } else {
            {   PH_BEGIN
                unsigned char* wd = ws + WS_WDIFF + (size_t)j * W_DIFF_SZ;
                run_gemm(ldsl, (const bf16*)(ws + WS_HO), 1024, (const bf16*)(wd + W_DIFF_IN), 4096, 1024, E5{ws, j}, tid, bxp, Gp);
            }
            xcd_barrier(xbar);
            {
                PH_BEGIN
                bf16* HO = (bf16*)(ws + WS_HO); const bf16* Qb = (const bf16*)(ws + WS_Q);
                const bf16* Kb = (const bf16*)(ws + WS_K); const bf16* Vb = (const bf16*)(ws + WS_V); const bf16* Gb = (const bf16*)(ws + WS_G);
                const float* PAR = (const float*)(ws + WS_PAR); float* STASH = (float*)(ws + WS_STASH);
                const float lam = __uint_as_float(__builtin_amdgcn_readfirstlane(__float_as_uint(PAR[j]))), omli = 1.0f - __uint_as_float(__builtin_amdgcn_readfirstlane(__float_as_uint(PAR[2 + j])));
                unsigned* CNT = (unsigned*)(ws + WS_AUX + AUX_CNT) + j * 64;
                const int* TMIN = (const int*)(ws + WS_AUX + AUX_TMIN); const int* TMAX = (const int*)(ws + WS_AUX + AUX_TMAX);
                const unsigned* KN2 = (const unsigned*)(ws + WS_AUX + AUX_KN2) + (size_t)j * 256 * 32; const unsigned* QN2 = (const unsigned*)(ws + WS_AUX + AUX_QN2) + (size_t)j * 64 * 32;
                volatile int* sm = (volatile int*)(lds + 98304); volatile unsigned long long* smask = (volatile unsigned long long*)(lds + 98304 + 64);
                for (;;) {
                    __syncthreads();
                    if (tidv == 0) sm[0] = (int)atomicAdd(CNT, 1u);
                    __syncthreads();
                    const int qi = sm[0]; if (qi >= NB * 8 * 32) break;
                    const int h = 7 - (qi >> 6), b = (qi >> 5) & 1, qb = qi & 31;
                    asm volatile("" : "+v"(tidv)); const int tid = tidv, lane = tid & 63;
                    const int r32 = lane & 31, hi = lane >> 5; const size_t row0 = (size_t)b * SEQ + qb * 256 + wave * 32;
                    const float cpos = exp2f(-(float)(h + 1)) * LOG2E, cneg = -cpos;
                    const float pq = (float)(a.pos + oz_)[row0 + r32];
                    f32x4* st = (f32x4*)(STASH + ((size_t)bxp * 512 + tid) * 64);
                    att::f32x16 o[4];
#pragma unroll 1
                    for (int c = 0; c < 2; ++c) {
                        {
                            const bf16* qd = Qb + (row0 + r32) * 1024 + h * 128 + c * 64 + hi * 8; const bf16* kd = Kb + (row0 + r32) * 1024 + h * 128 + c * 64 + hi * 8;
                            float sii = 0.f;
#pragma unroll
                            for (int d0 = 0; d0 < 4; ++d0) { const att::bf16x8 qv = *reinterpret_cast<const att::bf16x8*>(qd + d0 * 16), kv = *reinterpret_cast<const att::bf16x8*>(kd + d0 * 16);
#pragma unroll
                                for (int e = 0; e < 8; ++e) sii = fmaf(bf2f((bf16)qv[e]), bf2f((bf16)kv[e]), sii); }
                            sii = add_xor32(sii);
                            sii = fminf(sii, swz_xor<1>(sii)); sii = fminf(sii, swz_xor<2>(sii)); sii = fminf(sii, swz_xor<4>(sii)); sii = fminf(sii, swz_xor<8>(sii)); sii = fminf(sii, swz_xor<16>(sii));
                            if (lane == 0) ((volatile float*)(lds + 98304 + 128))[wave] = sii;
                        }
                        __syncthreads();
                        if (tid < 128) {
                            const volatile float* smin = (const volatile float*)(lds + 98304 + 128);
                            const float mlb = fminf(fminf(fminf(smin[0], smin[1]), fminf(smin[2], smin[3])), fminf(fminf(smin[4], smin[5]), fminf(smin[6], smin[7]))) - 0.05f;
                            const int hm2 = (h * 2 + c) * 2, t = tid;
                            const unsigned* qp = QN2 + ((size_t)b * 32 + qb) * 32 + hm2; const float qn = sqrtf(__uint_as_float(qp[0]) + __uint_as_float(qp[1]));
                            const unsigned* kp = KN2 + ((size_t)b * 128 + t) * 32 + hm2; const float kn = sqrtf(__uint_as_float(kp[0]) + __uint_as_float(kp[1]));
                            int qmin = 0x7fffffff, qmax = -0x7fffffff;
#pragma unroll
                            for (int i = 0; i < 4; ++i) { qmin = min(qmin, TMIN[b * 128 + 4 * qb + i]); qmax = max(qmax, TMAX[b * 128 + 4 * qb + i]); }
                            const int dmin = max(0, max(qmin - TMAX[b * 128 + t], TMIN[b * 128 + t] - qmax));
                            const bool keep = 1.03f * qn * kn - cpos * (float)dmin > mlb - 32.0f;
                            const unsigned long long mk = __ballot(keep);
                            float kb = qn * kn;
                            kb = fmaxf(kb, swz_xor<1>(kb)); kb = fmaxf(kb, swz_xor<2>(kb)); kb = fmaxf(kb, swz_xor<4>(kb)); kb = fmaxf(kb, swz_xor<8>(kb)); kb = fmaxf(kb, swz_xor<16>(kb));
                            { auto rr = __builtin_amdgcn_permlane32_swap(__float_as_uint(kb), __float_as_uint(kb), false, false); kb = fmaxf(__uint_as_float(rr[0]), __uint_as_float(rr[1])); }
                            if (lane == 0) { smask[tid >> 6] = mk; ((volatile float*)(lds + 98304 + 192))[tid >> 6] = kb; }
                        }
                        __syncthreads();
                        const float bnd = 1.03f * fmaxf(((volatile float*)(lds + 98304 + 192))[0], ((volatile float*)(lds + 98304 + 192))[1]) + 0.01f;
                        const unsigned long long m0 = smask[0], m1 = smask[1];
                        int t_lo = m0 ? __builtin_ctzll(m0) : 64 + __builtin_ctzll(m1 | (1ull << 63));
                        int t_hi = m1 ? 127 - __builtin_clzll(m1) : 63 - __builtin_clzll(m0 | 1ull);
                        t_lo = min(t_lo, 4 * qb); t_hi = max(t_hi, 4 * qb + 3);
                        if (bnd > 60.0f && ((t_hi - t_lo + 1) & 1) != 0) { if (t_hi < 127) ++t_hi; else --t_lo; }
                        t_lo = __builtin_amdgcn_readfirstlane(t_lo); t_hi = __builtin_amdgcn_readfirstlane(t_hi);
                        asm volatile("" : "+v"(tidv));
                        if (bnd <= 60.0f)
                        att::attn_diff1(Qb + (row0 + r32) * 1024 + h * 128 + c * 64 + hi * 8, Kb + (size_t)b * SEQ * 1024 + h * 128 + c * 64, Vb + (size_t)b * SEQ * 1024 + h * 128,
                                        (a.pos + oz_) + (size_t)b * SEQ, pq, cneg, (char*)lds, o, tidv, t_lo, t_hi - t_lo + 1, -bnd);
                        else
                        att::attn_pass<4, false, true, 1, false, false>(Qb + (row0 + r32) * 1024 + h * 128 + c * 64 + hi * 8, Kb + (size_t)b * SEQ * 1024 + h * 128 + c * 64, 1024, nullptr,
                                                       Vb + (size_t)b * SEQ * 1024 + h * 128, 1024, (a.pos + oz_) + (size_t)b * SEQ, pq, cneg, (char*)lds, o, tidv, t_lo, t_hi - t_lo + 1, 0.f);
                        if (c == 0) {
#pragma unroll
                            for (int d = 0; d < 4; ++d)
#pragma unroll
                                for (int r = 0; r < 4; ++r) st[d * 4 + r] = (f32x4){o[d][4 * r], o[d][4 * r + 1], o[d][4 * r + 2], o[d][4 * r + 3]};
                        }
                    }
                    float ss[16];
#pragma unroll
                    for (int r = 0; r < 16; ++r) ss[r] = 0.f;
#pragma unroll
                    for (int d = 0; d < 4; ++d)
#pragma unroll
                        for (int r = 0; r < 4; ++r) { const f32x4 s0 = st[d * 4 + r];
#pragma unroll
                            for (int q = 0; q < 4; ++q) { const float v = s0[q] - lam * o[d][4 * r + q]; o[d][4 * r + q] = v; ss[4 * r + q] += v * v; } }
#pragma unroll
                    for (int r = 0; r < 16; ++r) { float v = ss[r]; v += swz_xor<1>(v); v += swz_xor<2>(v); v += swz_xor<4>(v); v += swz_xor<8>(v); v += swz_xor<16>(v); ss[r] = v; }
                    const float* hg = (a.head_g + oz_) + j * 128;
#pragma unroll
                    for (int r = 0; r < 16; ++r) ss[r] = rsqrtf(ss[r] * (1.0f / 128.0f) + EPS) * omli;
                    float* stg = (float*)lds + (size_t)wave * (32 * 68);
#pragma unroll
                    for (int half = 0; half < 2; ++half) {
#pragma unroll
                        for (int r = 0; r < 16; ++r)
#pragma unroll
                            for (int d2 = 0; d2 < 2; ++d2) stg[att::crow(r, hi) * 68 + d2 * 32 + r32] = o[half * 2 + d2][r] * ss[r];
                        asm volatile("s_waitcnt lgkmcnt(0)" ::: "memory");
#pragma unroll
                        for (int i = 0; i < 4; ++i) { const int rw = i * 8 + (lane >> 3), cc = (lane & 7) * 8, col = half * 64 + cc;
                            const f32x4 v0 = *(const f32x4*)(stg + rw * 68 + cc), v1 = *(const f32x4*)(stg + rw * 68 + cc + 4);
                            const size_t off = (row0 + rw) * 1024 + h * 128 + col;
                            const u32x4 g = *(const u32x4*)(Gb + off);
                            const f32x4 g0 = {__uint_as_float(g.x << 16), __uint_as_float(g.x & 0xffff0000u), __uint_as_float(g.y << 16), __uint_as_float(g.y & 0xffff0000u)};
                            const f32x4 g1 = {__uint_as_float(g.z << 16), __uint_as_float(g.z & 0xffff0000u), __uint_as_float(g.w << 16), __uint_as_float(g.w & 0xffff0000u)};
                            const f32x4 h0 = *(const f32x4*)(hg + col), h1 = *(const f32x4*)(hg + col + 4);
                            st8(HO + off, v0 * h0 * g0, v1 * h1 * g1); }
                        asm volatile("s_waitcnt lgkmcnt(0)" ::: "memory");
                    }
                }
            }
            xcd_barrier(xbar);
            {   PH_BEGIN
                unsigned char* wd = ws + WS_WDIFF + (size_t)j * W_DIFF_SZ; const float* xin = (a.out + oz_);
                run_gemm(ldsl, (const bf16*)(ws + WS_HO), 1024, (const bf16*)(wd + W_DIFF_O), 1024, 1024, E4{ws, xin, (a.out + oz_), l}, tid, bxp, Gp);
            }
            xcd_barrier(xbar);
        }
    }
    {
        PH_BEGIN
        for (int m = bxp * 8 + wave; m < M; m += Gp * 8) {
            f32x4* xr = (f32x4*)((a.out + oz_) + (size_t)m * D) + lane; f32x4 v[4]; float s = 0.f;
#pragma unroll
            for (int q = 0; q < 4; ++q) { v[q] = xr[64 * q]; s += dot4(v[q]); }
            const float r = rsqrtf(wave_sum(s) * (1.0f / D) + EPS);
#pragma unroll
            for (int q = 0; q < 4; ++q) { const f32x4 gg = *(const f32x4*)((a.final_g + oz_) + 4 * lane + 256 * q); xr[64 * q] = (v[q] * r) * gg; }
        }
    }
}

extern "C" void kernel_launch(void* const* d_in, const int* in_sizes, int n_in, void* d_out, int out_size, void* d_ws, size_t ws_size, hipStream_t stream) {
    static int grid_blocks = 0;
    if (grid_blocks == 0) {
        if (n_in != 20 || in_sizes[0] != M * D || out_size != M * D || ws_size < WS_END) { fprintf(stderr, "kernel_launch: unexpected shapes (n_in %d, in0 %d, out %d, ws %zu)\n", n_in, n_in > 0 ? in_sizes[0] : -1, out_size, ws_size); grid_blocks = -1; return; }
        int dev = 0, cus = 0, per_cu = 0;
        hipGetDevice(&dev); hipDeviceGetAttribute(&cus, hipDeviceAttributeMultiprocessorCount, dev);
        if (hipFuncSetAttribute((const void*)fwd_kernel, hipFuncAttributeMaxDynamicSharedMemorySize, LDS_BYTES) != hipSuccess) { fprintf(stderr, "kernel_launch: hipFuncSetAttribute failed\n"); grid_blocks = -1; return; }
        hipOccupancyMaxActiveBlocksPerMultiprocessor(&per_cu, (const void*)fwd_kernel, 512, LDS_BYTES);
        if (per_cu < 1) per_cu = 1;
        grid_blocks = cus * per_cu;
        (void)hipGetLastError();
    }
    if (grid_blocks < 0) return;
    Args a{};
    a.x = (const float*)d_in[0]; a.c = (const float*)d_in[1]; a.pos = (const int*)d_in[2]; a.ada_w = (const float*)d_in[3]; a.ada_b = (const float*)d_in[4]; a.norm_g = (const float*)d_in[5];
    a.mla_w_in = (const float*)d_in[6]; a.mla_qg = (const float*)d_in[7]; a.mla_wq = (const float*)d_in[8]; a.mla_kvg = (const float*)d_in[9]; a.mla_wkv = (const float*)d_in[10]; a.mla_wo = (const float*)d_in[11];
    a.diff_w_in = (const float*)d_in[12]; a.lq1 = (const float*)d_in[13]; a.lk1 = (const float*)d_in[14]; a.lq2 = (const float*)d_in[15]; a.lk2 = (const float*)d_in[16]; a.head_g = (const float*)d_in[17];
    a.diff_wo = (const float*)d_in[18]; a.final_g = (const float*)d_in[19];
    a.out = (float*)d_out; a.ws = (unsigned char*)d_ws;
    void* args[] = {&a};
    hipError_t e = hipLaunchCooperativeKernel((const void*)fwd_kernel, dim3(grid_blocks), dim3(512), args, LDS_BYTES, stream);
    if (e != hipSuccess) fprintf(stderr, "cooperative launch failed: %s (grid %d)\n", hipGetErrorString(e), grid_blocks);
}
```

```cpp
#include <hip/hip_runtime.h>
#include <hip/hip_cooperative_groups.h>
#include <cstdio>
#include <cstdint>
namespace cg = cooperative_groups;
namespace pg8 {
#define PG8_LAS __attribute__((address_space(3)))
typedef unsigned short bf16_t;
typedef short bf16x8 __attribute__((ext_vector_type(8)));
typedef float f32x4 __attribute__((ext_vector_type(4)));
typedef unsigned u32x4 __attribute__((ext_vector_type(4)));
constexpr int BM = 256, BK = 64, HALF = 128, HTB = HALF * BK * 2  , STAGE_BYTES = 8 * HTB, NXCD = 8, WGM = 8;

__host__ __device__ __forceinline__ int lds_byte(int r, int c) { const int st = (r >> 4) * 2 + (c >> 5), rr = r & 15, cc = c & 31, ob = rr * 64 + cc * 2; return st * 1024 + (ob ^ (((ob >> 9) & 1) << 5)); }
__host__ __device__ __forceinline__ void stage_rc(int b, int& R, int& C) { const int st = b / 1024, sb = b % 1024, swz = sb ^ (((sb >> 9) & 1) << 5); R = (st >> 1) * 16 + swz / 64; C = (st & 1) * 32 + (swz % 64) / 2; }
__host__ __device__ __forceinline__ int perm32(int rho) { const int n = rho >> 4, i = rho & 15; return 8 * (i >> 2) + 4 * n + (i & 3); }

struct Unit { int pm, pn; };
struct Gemm { const bf16_t* A; const bf16_t* Bt; int M, N, K, lda; };

struct StaticOrder {
    int nM, nN, nwg, G, c;
    __host__ __device__ void init(int M, int N, int G_, int c_) { nM = M / BM; nN = N / BM; nwg = nM * nN; G = G_; c = c_; }
    __host__ __device__ bool next(int i, Unit& u) const {
        const long L = (long)i * G + c; if (L >= nwg) return false;
        int wgid = (int)L; { const int q = nwg / NXCD, r = nwg % NXCD, xcd = wgid % NXCD, off = wgid / NXCD; wgid = (xcd < r ? xcd * (q + 1) : r * (q + 1) + (xcd - r) * q) + off; }
        const int nig = WGM * nN, gid = wgid / nig, fm = gid * WGM, gsz = (nM - fm) < WGM ? (nM - fm) : WGM;
        u.pm = fm + ((wgid % nig) % gsz); u.pn = (wgid % nig) / gsz; return true;
    }
    __device__ __forceinline__ void a_ready(const Unit&) const {}
    __device__ __forceinline__ void done(const Unit&) const {}
};
template <class F> struct EpiF {
    static constexpr bool PERM = F::PERM, AFTER_DRAIN = false;
    F f;
    __device__ __forceinline__ void operator()(const f32x4 (&acc)[2][2][4][2], const Unit& u, int wr, int wc, int fr, int fq) const {
        F g = f; g.launder();
#pragma unroll
        for (int ai = 0; ai < 2; ++ai)
#pragma unroll
            for (int m = 0; m < 4; ++m) { const int row = u.pm * BM + ai * HALF + wr * 64 + m * 16 + fr;
#pragma unroll
                for (int bj = 0; bj < 2; ++bj) { const int col = u.pn * BM + bj * HALF + wc * 32 + (PERM ? 8 : 4) * fq; g(row, col, acc[ai][bj][m][0], acc[ai][bj][m][1]); }
                asm volatile("" ::: "memory"); }
    }
};
template <class Epi, class Sched, bool ALIGN_EPI = false, bool SP2 = false>
__device__ __forceinline__ void gemm_phase(PG8_LAS unsigned char* lds, const Gemm g, const Sched& S, const Epi& E, const int tid) {
    const int wid = __builtin_amdgcn_readfirstlane(tid >> 6), lane = tid & 63, wr = wid >> 2, wc = wid & 3, fr = lane & 15, fq = lane >> 4;
    const int K = g.K, nt = K / BK;
    unsigned voffA[2], voffB[2];
#pragma unroll
    for (int i = 0; i < 2; ++i) { int R, C; stage_rc(tid * 16 + i * 8192, R, C); const int Rb = Epi::PERM ? ((R & ~31) + perm32(R & 31)) : R;
        voffA[i] = (unsigned)(R * g.lda + C) * 2u; voffB[i] = (unsigned)(Rb * K + C) * 2u; }
    const size_t kstep = (size_t)(BK * 2);
    const size_t hstep = (size_t)HALF * K * 2, hstepA = (size_t)HALF * g.lda * 2;
    const size_t tstep = 2 * hstep, tstepA = 2 * hstepA;
    const unsigned ldsw = (unsigned)wid * 1024u;
    const int aoff = lds_byte(wr * 64 + fr, fq * 8), boff = lds_byte(wc * 32 + fr, fq * 8);
#define PG8_SA(b, h) (((b) * 2 + (h)) * HTB)
#define PG8_SB(b, h) ((4 + (b) * 2 + (h)) * HTB)
#define PG8_STAGE(bufoff, gbase, voff) do { _Pragma("unroll") for (int _i = 0; _i < 2; ++_i) \
        __builtin_amdgcn_global_load_lds((const unsigned*)((const char*)(gbase) + (voff)[_i]), (PG8_LAS unsigned*)(lds + (bufoff) + ldsw + _i * 8192), 16, 0, 0); } while (0)
#define PG8_LDA(dst, b, h) do { _Pragma("unroll") for (int m = 0; m < 4; ++m) _Pragma("unroll") for (int k = 0; k < 2; ++k) dst[m][k] = *(const PG8_LAS bf16x8*)(lds + PG8_SA(b, h) + aoff + m * 2048 + k * 1024); } while (0)
#define PG8_LDB(dst, b, h) do { _Pragma("unroll") for (int n = 0; n < 2; ++n) _Pragma("unroll") for (int k = 0; k < 2; ++k) dst[n][k] = *(const PG8_LAS bf16x8*)(lds + PG8_SB(b, h) + boff + n * 2048 + k * 1024); } while (0)
#define PG8_MMA(ai, bj, At, Bt) do { __builtin_amdgcn_s_setprio(1); _Pragma("unroll") for (int m = 0; m < 4; ++m) _Pragma("unroll") for (int n = 0; n < 2; ++n) _Pragma("unroll") for (int k = 0; k < 2; ++k) \
        acc[ai][bj][m][n] = __builtin_amdgcn_mfma_f32_16x16x32_bf16(Bt[n][k], At[m][k], acc[ai][bj][m][n], 0, 0, 0); __builtin_amdgcn_s_setprio(0); } while (0)
#define PG8_WAIT_V(n) asm volatile("s_waitcnt vmcnt(" #n ")" ::: "memory")
#define PG8_WAIT_L(n) asm volatile("s_waitcnt lgkmcnt(" #n ")" ::: "memory")
#define PG8_BAR __builtin_amdgcn_s_barrier()
#define PG8_SCHED __builtin_amdgcn_sched_barrier(0)
    Unit cur, nxt; int ui = 0;
    if (!S.next(0, cur)) return;
    f32x4 acc[2][2][4][2];
#pragma unroll
    for (int a = 0; a < 2; ++a)
#pragma unroll
        for (int b = 0; b < 2; ++b)
#pragma unroll
            for (int m = 0; m < 4; ++m)
#pragma unroll
                for (int n = 0; n < 2; ++n) acc[a][b][m][n] = (f32x4){0.f, 0.f, 0.f, 0.f};
    bf16x8 At[4][2], B0[2][2], B1[2][2];
    const char* cA = (const char*)g.A + (size_t)cur.pm * tstepA; const char* cB = (const char*)g.Bt + (size_t)cur.pn * tstep;
    S.a_ready(cur);
    if constexpr (SP2) {
        PG8_STAGE(PG8_SB(0, 0), cB, voffB); PG8_STAGE(PG8_SB(0, 1), cB + hstep, voffB); PG8_STAGE(PG8_SA(0, 0), cA, voffA); PG8_STAGE(PG8_SA(0, 1), cA + hstepA, voffA);
        if (wr == 1) PG8_BAR;
        PG8_WAIT_V(2); PG8_BAR;
        PG8_STAGE(PG8_SB(1, 0), cB + kstep, voffB); PG8_STAGE(PG8_SA(1, 0), cA + kstep, voffA); PG8_STAGE(PG8_SB(1, 1), cB + hstep + kstep, voffB);
        PG8_WAIT_V(6); PG8_BAR;
    } else {
        PG8_STAGE(PG8_SB(0, 0), cB, voffB); PG8_STAGE(PG8_SA(0, 0), cA, voffA); PG8_STAGE(PG8_SB(0, 1), cB + hstep, voffB); PG8_STAGE(PG8_SA(0, 1), cA + hstepA, voffA);
        if (wr == 1) PG8_BAR;
        PG8_WAIT_V(4); PG8_BAR;
        PG8_STAGE(PG8_SB(1, 0), cB + kstep, voffB); PG8_STAGE(PG8_SA(1, 0), cA + kstep, voffA); PG8_STAGE(PG8_SB(1, 1), cB + hstep + kstep, voffB);
        PG8_WAIT_V(6); PG8_BAR;
    }
    for (;;) {
        const bool has_next = S.next(ui + 1, nxt);
        const char* nA = has_next ? (const char*)g.A + (size_t)nxt.pm * tstepA : cA; const char* nB = has_next ? (const char*)g.Bt + (size_t)nxt.pn * tstep : cB;
        for (int t = 0; t < nt; t += 2) {
            const bool last = (t == nt - 2);
            const char* a1 = cA + (size_t)(t + 1) * kstep;
            const char* a2 = last ? nA : cA + (size_t)(t + 2) * kstep; const char* b2 = last ? nB : cB + (size_t)(t + 2) * kstep;
            const char* a3 = a2 + kstep; const char* b3 = b2 + kstep;
            if (last && has_next) S.a_ready(nxt);
            if constexpr (SP2) {
            PG8_LDB(B0, 0, 0); PG8_LDB(B1, 0, 1); PG8_SCHED; PG8_LDA(At, 0, 0); PG8_STAGE(PG8_SA(1, 1), a1 + hstepA, voffA);
            PG8_WAIT_V(8); PG8_WAIT_L(0); PG8_BAR; PG8_MMA(0, 0, At, B0); PG8_MMA(0, 1, At, B1); PG8_BAR; PG8_SCHED;
            PG8_LDA(At, 0, 1); PG8_STAGE(PG8_SB(0, 0), b2, voffB); PG8_STAGE(PG8_SB(0, 1), b2 + hstep, voffB); PG8_STAGE(PG8_SA(0, 0), a2, voffA);
            PG8_WAIT_V(8); PG8_WAIT_L(0); PG8_BAR; PG8_MMA(1, 0, At, B0); PG8_MMA(1, 1, At, B1); PG8_BAR; PG8_SCHED;
            PG8_LDB(B0, 1, 0); PG8_LDB(B1, 1, 1); PG8_SCHED; PG8_LDA(At, 1, 0); PG8_STAGE(PG8_SA(0, 1), a2 + hstepA, voffA);
            PG8_WAIT_V(8); PG8_WAIT_L(0); PG8_BAR; PG8_MMA(0, 0, At, B0); PG8_MMA(0, 1, At, B1); PG8_BAR; PG8_SCHED;
            PG8_LDA(At, 1, 1); PG8_STAGE(PG8_SB(1, 0), b3, voffB); PG8_STAGE(PG8_SB(1, 1), b3 + hstep, voffB); PG8_STAGE(PG8_SA(1, 0), a3, voffA);
            PG8_WAIT_V(8); PG8_WAIT_L(0); PG8_BAR; PG8_MMA(1, 0, At, B0); PG8_MMA(1, 1, At, B1); PG8_BAR; PG8_SCHED;
            } else {
            PG8_LDB(B0, 0, 0); PG8_SCHED; PG8_LDA(At, 0, 0); PG8_STAGE(PG8_SA(1, 1), a1 + hstepA, voffA);
            PG8_WAIT_L(8); PG8_BAR; PG8_WAIT_L(0); PG8_MMA(0, 0, At, B0); PG8_BAR; PG8_SCHED;
            PG8_LDB(B1, 0, 1); PG8_STAGE(PG8_SB(0, 0), b2, voffB);
            PG8_BAR; PG8_WAIT_L(0); PG8_MMA(0, 1, At, B1); PG8_BAR;
            PG8_LDA(At, 0, 1); PG8_STAGE(PG8_SA(0, 0), a2, voffA);
            PG8_BAR; PG8_WAIT_L(0); PG8_MMA(1, 0, At, B0); PG8_BAR; PG8_SCHED;
            PG8_STAGE(PG8_SB(0, 1), b2 + hstep, voffB);
            PG8_WAIT_V(6); PG8_BAR; PG8_MMA(1, 1, At, B1); PG8_BAR;
            PG8_LDB(B0, 1, 0); PG8_SCHED; PG8_LDA(At, 1, 0); PG8_STAGE(PG8_SA(0, 1), a2 + hstepA, voffA);
            PG8_WAIT_L(8); PG8_BAR; PG8_WAIT_L(0); PG8_MMA(0, 0, At, B0); PG8_BAR; PG8_SCHED;
            PG8_LDB(B1, 1, 1); PG8_STAGE(PG8_SB(1, 0), b3, voffB);
            PG8_BAR; PG8_WAIT_L(0); PG8_MMA(0, 1, At, B1); PG8_BAR;
            PG8_LDA(At, 1, 1); PG8_STAGE(PG8_SA(1, 0), a3, voffA);
            PG8_BAR; PG8_WAIT_L(0); PG8_MMA(1, 0, At, B0); PG8_BAR; PG8_SCHED;
            PG8_STAGE(PG8_SB(1, 1), b3 + hstep, voffB);
            PG8_WAIT_V(6); PG8_BAR; PG8_MMA(1, 1, At, B1); PG8_BAR;
            }
        }
        if constexpr (ALIGN_EPI) { if (wr == 0) PG8_BAR; }
        if constexpr (!Epi::AFTER_DRAIN) { E(acc, cur, wr, wc, fr, fq); S.done(cur); }
        if (!has_next) break;
#pragma unroll
        for (int a = 0; a < 2; ++a)
#pragma unroll
            for (int b = 0; b < 2; ++b)
#pragma unroll
                for (int m = 0; m < 4; ++m)
#pragma unroll
                    for (int n = 0; n < 2; ++n) acc[a][b][m][n] = (f32x4){0.f, 0.f, 0.f, 0.f};
        cur = nxt; cA = nA; cB = nB; ++ui;
        if constexpr (ALIGN_EPI) { if (wr == 1) PG8_BAR; }
    }
    PG8_WAIT_V(0);
    if constexpr (!ALIGN_EPI) { if (wr == 0) PG8_BAR; }
    PG8_BAR;
    if constexpr (Epi::AFTER_DRAIN) { E.fused(acc, cur, wr, wc, fr, fq, lds, wid, lane); S.done(cur); }
#undef PG8_SA
#undef PG8_SB
#undef PG8_STAGE
#undef PG8_LDA
#undef PG8_LDB
#undef PG8_MMA
#undef PG8_WAIT_V
#undef PG8_WAIT_L
#undef PG8_BAR
#undef PG8_SCHED
}
}

constexpr int SEQ = 8192, NB = 2, M = NB * SEQ, D = 1024, DEPTH = 4;
constexpr float EPS = 1e-6f;
constexpr float LOG2E = 1.4426950408889634f;
constexpr float QSCALE_MLA = 0.10206207261596577f * LOG2E;
constexpr float QSCALE_DIFF = 0.125f * LOG2E;
constexpr int MLA_IN = 1696, MLA_IN_PAD = 1792;

typedef unsigned short bf16;
typedef float f32x4 __attribute__((ext_vector_type(4)));
typedef unsigned u32x2 __attribute__((ext_vector_type(2)));
typedef unsigned u32x4 __attribute__((ext_vector_type(4)));
#define LAS __attribute__((address_space(3)))

constexpr size_t MiB = 1u << 20;
constexpr size_t WS_MOD = 0;
constexpr size_t WS_PAR = 128 * 1024;
constexpr size_t WS_SSQ = 256 * 1024;
constexpr size_t WS_AUX = 512 * 1024;
constexpr size_t AUX_TMIN = 0, AUX_TMAX = 1024;
constexpr size_t AUX_KN2 = 4096;
constexpr size_t AUX_QN2 = AUX_KN2 + 65536;
constexpr size_t AUX_CNT = AUX_QN2 + 16384;
constexpr size_t AUX_KNM = AUX_CNT + 512;
constexpr size_t AUX_KRM = AUX_KNM + 512;
constexpr size_t AUX_ZERO_WORDS = (65536 + 16384 + 512 + 512 + 512) / 4;
constexpr size_t WS_BAR = 768 * 1024;
constexpr size_t WS_COS = 1 * MiB, WS_SIN = 2 * MiB;
constexpr size_t WS_W = 4 * MiB;
constexpr size_t W_MLA_IN = 0, W_MLA_Q = W_MLA_IN + (size_t)MLA_IN_PAD * 1024 * 2, W_MLA_KV = W_MLA_Q + (size_t)1536 * 384 * 2,
                 W_MLA_O = W_MLA_KV + (size_t)2048 * 256 * 2, W_MLA_SZ = W_MLA_O + (size_t)1024 * 1024 * 2;
constexpr size_t W_DIFF_IN = 0, W_DIFF_O = (size_t)4096 * 1024 * 2, W_DIFF_SZ = W_DIFF_O + (size_t)1024 * 1024 * 2;
constexpr size_t WS_WMLA = WS_W, WS_WDIFF = WS_W + 2 * W_MLA_SZ;
static_assert(WS_WDIFF + 2 * W_DIFF_SZ <= 40 * MiB, "weights fit");
constexpr size_t WS_HO = 40 * MiB;
constexpr size_t WS_Q = 72 * MiB;
constexpr size_t WS_STASH = 104 * MiB;
constexpr size_t WS_QL = 120 * MiB;
constexpr size_t WS_KVL = 132 * MiB;
constexpr size_t WS_KR = 140 * MiB;
constexpr size_t WS_K = 142 * MiB;
constexpr size_t WS_V = 174 * MiB;
constexpr size_t WS_G = 206 * MiB;
constexpr size_t WS_END = 238 * MiB;

constexpr int LDS_BYTES = 135168;

__device__ __forceinline__ unsigned cvtpk(float lo, float hi) { unsigned r; asm volatile("v_cvt_pk_bf16_f32 %0, %1, %2" : "=v"(r) : "v"(lo), "v"(hi)); return r; }
__device__ __forceinline__ void st4(bf16* p, f32x4 v) { u32x2 w; w.x = cvtpk(v[0], v[1]); w.y = cvtpk(v[2], v[3]); *(u32x2*)p = w; }
__device__ __forceinline__ float bf2f(bf16 b) { return __uint_as_float((unsigned)b << 16); }
__device__ __forceinline__ float silu1(float v) { return v * __builtin_amdgcn_rcpf(1.0f + __expf(-v)); }
__device__ __forceinline__ f32x4 silu4(f32x4 v) { return (f32x4){silu1(v[0]), silu1(v[1]), silu1(v[2]), silu1(v[3])}; }
__device__ __forceinline__ float dot4(f32x4 a) { return (a[0] * a[0] + a[1] * a[1]) + (a[2] * a[2] + a[3] * a[3]); }
template <int X> __device__ __forceinline__ float swz_xor(float v) { return __int_as_float(__builtin_amdgcn_ds_swizzle(__float_as_int(v), (X << 10) | 0x1f)); }
__device__ __forceinline__ float add_xor32(float v) { auto rr = __builtin_amdgcn_permlane32_swap(__float_as_uint(v), __float_as_uint(v), false, false); return __uint_as_float(rr[0]) + __uint_as_float(rr[1]); }
__device__ __forceinline__ float wave_sum(float v) {
    v += swz_xor<1>(v); v += swz_xor<2>(v); v += swz_xor<4>(v); v += swz_xor<8>(v); v += swz_xor<16>(v); return add_xor32(v);
}

__device__ __forceinline__ void st8(bf16* p, f32x4 a, f32x4 b) { u32x4 w; w.x = cvtpk(a[0], a[1]); w.y = cvtpk(a[2], a[3]); w.z = cvtpk(b[0], b[1]); w.w = cvtpk(b[2], b[3]); *(u32x4*)p = w; }
__device__ __forceinline__ void rope8(f32x4& a, f32x4& b, const float* rc_row, const float* rs_row, int ci) {
    const bool upper = ci >= 16; const int i = ci & 15;
    f32x4 pa, pb;
#pragma unroll
    for (int e = 0; e < 4; ++e) {
        auto ra = __builtin_amdgcn_permlane32_swap(__float_as_uint(a[e]), __float_as_uint(a[e]), false, false); pa[e] = __uint_as_float(upper ? ra[0] : ra[1]);
        auto rb = __builtin_amdgcn_permlane32_swap(__float_as_uint(b[e]), __float_as_uint(b[e]), false, false); pb[e] = __uint_as_float(upper ? rb[0] : rb[1]);
    }
    const f32x4 c0 = *(const f32x4*)(rc_row + i), c1 = *(const f32x4*)(rc_row + i + 4), s0 = *(const f32x4*)(rs_row + i), s1 = *(const f32x4*)(rs_row + i + 4);
    if (!upper) { a = a * c0 - pa * s0; b = b * c1 - pb * s1; }
    else { a = pa * s0 + a * c0; b = pb * s1 + b * c1; }
}
template <class T> __device__ __forceinline__ T* opaque_uniform(T* p) { asm volatile("" : "+s"(p)); return p; }
__device__ __forceinline__ int opaque_u32(unsigned v) { asm volatile("" : "+s"(v)); return (int)v; }
__device__ __forceinline__ void atomic_max_f32_filtered(unsigned* p, float v) { if (v > __uint_as_float(*(volatile unsigned*)p)) atomicMax(p, __float_as_uint(v)); }
#define LAUNDER_WS __device__ __forceinline__ void launder() { ws += (size_t)(unsigned)opaque_u32(0u); }
struct E1 {
    static constexpr bool PERM = true;
    unsigned char* ws; int j; LAUNDER_WS
    __device__ __forceinline__ void operator()(int row, int col, f32x4 a, f32x4 b) const {
        bf16 *QL = (bf16*)(ws + WS_QL), *KVL = (bf16*)(ws + WS_KVL), *KR = (bf16*)(ws + WS_KR), *G = (bf16*)(ws + WS_G);
        float *ssq_q = (float*)(ws + WS_SSQ) + (size_t)j * 2 * M, *ssq_kv = ssq_q + M; const float *rc = (const float*)(ws + WS_COS), *rs = (const float*)(ws + WS_SIN);
        const int cb = col & ~31, ci = col & 31;
        if (cb < 384) {
            st8(QL + (size_t)row * 384 + col, a, b);
            float s = dot4(a) + dot4(b); s += swz_xor<16>(s); s = add_xor32(s);
            if (ci == 0) atomicAdd(ssq_q + row, s);
        } else if (cb < 640) {
            st8(KVL + (size_t)row * 256 + (col - 384), a, b);
            float s = dot4(a) + dot4(b); s += swz_xor<16>(s); s = add_xor32(s);
            if (ci == 0) atomicAdd(ssq_kv + row, s);
        } else if (cb < 672) {
            rope8(a, b, rc + (size_t)row * 16, rs + (size_t)row * 16, ci);
            st8(KR + (size_t)row * 32 + ci, a, b);
            float n2 = dot4(a) + dot4(b); n2 += swz_xor<16>(n2); n2 = add_xor32(n2);
            n2 = fmaxf(n2, swz_xor<1>(n2)); n2 = fmaxf(n2, swz_xor<2>(n2)); n2 = fmaxf(n2, swz_xor<4>(n2)); n2 = fmaxf(n2, swz_xor<8>(n2));
            if ((ci | (row & 15)) == 0) atomic_max_f32_filtered((unsigned*)(ws + WS_AUX + AUX_KRM) + (j * 2 + (row >> 13)) * 16, n2);
        } else if (cb < MLA_IN) {
            st8(G + (size_t)row * 1024 + (col - 672), silu4(a), silu4(b));
        }
    }
};
struct E2 {
    static constexpr bool PERM = true;
    unsigned char* ws; int j; LAUNDER_WS
    __device__ __forceinline__ void operator()(int row, int col, f32x4 a, f32x4 b) const {
        bf16* Q = (bf16*)(ws + WS_Q); const float* ssq_q = (const float*)(ws + WS_SSQ) + (size_t)j * 2 * M; const float *rc = (const float*)(ws + WS_COS), *rs = (const float*)(ws + WS_SIN);
        const float r = rsqrtf(ssq_q[row] * (1.0f / 384.0f) + EPS) * QSCALE_MLA; a = a * r; b = b * r;
        const int cb = col >> 5, ci = col & 31;
        if ((cb % 3) == 2) rope8(a, b, rc + (size_t)row * 16, rs + (size_t)row * 16, ci);
        st8(Q + (size_t)row * 1536 + col, a, b);
    }
};
struct E3 {
    static constexpr bool PERM = true;
    unsigned char* ws; int j; LAUNDER_WS
    __device__ __forceinline__ void operator()(int row, int col, f32x4 a, f32x4 b) const {
        bf16 *K = (bf16*)(ws + WS_K), *V = (bf16*)(ws + WS_V); const float* ssq_kv = (const float*)(ws + WS_SSQ) + (size_t)j * 2 * M + M;
        const float r = rsqrtf(ssq_kv[row] * (1.0f / 256.0f) + EPS); a = a * r; b = b * r;
        const int head = col >> 7, w = col & 127;
        const size_t off = (size_t)row * 1024 + head * 64 + (w & 63);
        if (w < 64) { st8(K + off, a, b);
            float n2 = dot4(a) + dot4(b); n2 += swz_xor<16>(n2); n2 = add_xor32(n2);
            n2 = fmaxf(n2, swz_xor<1>(n2)); n2 = fmaxf(n2, swz_xor<2>(n2)); n2 = fmaxf(n2, swz_xor<4>(n2)); n2 = fmaxf(n2, swz_xor<8>(n2));
            if (((col & 31) | (row & 15)) == 0) atomic_max_f32_filtered((unsigned*)(ws + WS_AUX + AUX_KNM) + (j * 2 + (row >> 13)) * 32 + head * 2 + ((col >> 5) & 1), n2);
        } else st8(V + off, a, b);
    }
};
struct E4 {
    static constexpr bool PERM = false;
    unsigned char* ws; const float* xin; float* xout; int l; LAUNDER_WS
    __device__ __forceinline__ void operator()(int row, int col, f32x4 a, f32x4 b) const {
        const float* gp = (const float*)(ws + WS_MOD) + l * 6144 + 2048 + (row >> 13) * 3072 + col; const size_t off = (size_t)row * 1024 + col;
        const f32x4 g0 = *(const f32x4*)gp, g1 = *(const f32x4*)(gp + 16);
        const f32x4 x0 = *(const f32x4*)(xin + off), x1 = *(const f32x4*)(xin + off + 16);
        *(f32x4*)(xout + off) = x0 + g0 * a; *(f32x4*)(xout + off + 16) = x1 + g1 * b;
    }
};
struct E5 {
    static constexpr bool PERM = true;
    unsigned char* ws; int j; LAUNDER_WS
    __device__ __forceinline__ void operator()(int row, int col, f32x4 a, f32x4 b) const {
        bf16 *Qd = (bf16*)(ws + WS_Q), *Kd = (bf16*)(ws + WS_K), *Vd = (bf16*)(ws + WS_V), *G = (bf16*)(ws + WS_G);
        const int reg = col >> 10, c2 = col & 1023; const size_t off = (size_t)row * 1024 + c2;
        if (reg <= 1) {
            if (reg == 0) { a = a * QSCALE_DIFF; b = b * QSCALE_DIFF; st8(Qd + off, a, b); }
            else st8(Kd + off, a, b);
            float s = dot4(a) + dot4(b); s += swz_xor<16>(s); s = add_xor32(s);
            s = fmaxf(s, swz_xor<1>(s)); s = fmaxf(s, swz_xor<2>(s)); s = fmaxf(s, swz_xor<4>(s)); s = fmaxf(s, swz_xor<8>(s));
            if (((col & 31) | (row & 15)) == 0) {
                unsigned* p = (reg == 0) ? (unsigned*)(ws + WS_AUX + AUX_QN2) + ((size_t)j * 64 + (row >> 8)) * 32 + (c2 >> 5)
                                         : (unsigned*)(ws + WS_AUX + AUX_KN2) + ((size_t)j * 256 + (row >> 6)) * 32 + (c2 >> 5);
                atomic_max_f32_filtered(p, s);
            }
        }
        else if (reg == 2) st8(Vd + off, a, b);
        else st8(G + off, silu4(a), silu4(b));
    }
};

namespace att {
using bf16x8 = __attribute__((ext_vector_type(8))) short;
using s16x4 = __attribute__((ext_vector_type(4))) short;
using f32x16 = __attribute__((ext_vector_type(16))) float;
constexpr int KN_OFF = 0, KR_OFF = 9216, V_OFF = 14336, PK_OFF = 30720, BUF = 30976, WSF_OFF = 3 * BUF, ATT_LDS = WSF_OFF + 2048;
constexpr float THR = 8.0f;
#define SBAR() __builtin_amdgcn_sched_barrier(0)
__device__ __forceinline__ int crow(int r, int hi) { return (r & 3) + 8 * (r >> 2) + 4 * hi; }
template <int DVB> __device__ __forceinline__ int v_st(int k, int c) { const int kk = (k & ~0xC) | ((k & 4) << 1) | ((k & 8) >> 1); return ((kk >> 3) * DVB + (c >> 5)) * 512 + ((kk & 7) * 32 + (c & 31)) * 2; }
__device__ __forceinline__ int v_rd_base(int lane) { return ((lane & 3) << 3) | (((lane >> 2) & 3) << 6) | (((lane >> 4) & 1) << 5) | (((lane >> 5) & 1) << 8); }
template <int OFF> __device__ __forceinline__ s16x4 tr_read(int vb) { s16x4 r; asm volatile("ds_read_b64_tr_b16 %0, %1 offset:%2" : "=&v"(r) : "v"(vb), "i"(OFF) : "memory"); return r; }

template <bool BIAS>
__device__ __forceinline__ void partialSM(f32x16& p0, f32x16& p1, float& m_reg, float& alpha, const char* pkl, int hi, float pq, float cneg) {
    if constexpr (BIAS) {
#pragma unroll
        for (int i = 0; i < 4; ++i) {
            const f32x4 k0 = *(const f32x4*)(pkl + (8 * i + 4 * hi) * 4), k1 = *(const f32x4*)(pkl + (32 + 8 * i + 4 * hi) * 4);
#pragma unroll
            for (int j = 0; j < 4; ++j) { p0[4 * i + j] = fmaf(fabsf(pq - k0[j]), cneg, p0[4 * i + j]); p1[4 * i + j] = fmaf(fabsf(pq - k1[j]), cneg, p1[4 * i + j]); }
        }
    }
    float pmax = p0[0];
#pragma unroll
    for (int r = 1; r < 16; ++r) pmax = fmaxf(pmax, p0[r]);
#pragma unroll
    for (int r = 0; r < 16; ++r) pmax = fmaxf(pmax, p1[r]);
    { auto rr = __builtin_amdgcn_permlane32_swap(__float_as_uint(pmax), __float_as_uint(pmax), false, false); pmax = fmaxf(__uint_as_float(rr[0]), __uint_as_float(rr[1])); }
    float mn;
    if (__builtin_expect(__all(pmax - m_reg <= THR), 1)) { mn = m_reg; alpha = 1.f; }
    else { mn = fmaxf(m_reg, pmax); alpha = __builtin_amdgcn_exp2f(m_reg - mn); m_reg = mn; }
#pragma unroll
    for (int r = 0; r < 16; ++r) p0[r] = __builtin_amdgcn_exp2f(p0[r] - mn);
#pragma unroll
    for (int r = 0; r < 16; ++r) p1[r] = p1[r] - mn;
}
__device__ __forceinline__ void finishSM(f32x16& p0, f32x16& p1, float alpha, float& l_reg, bf16x8& pa0, bf16x8& pa1, bf16x8& pa2, bf16x8& pa3) {
#pragma unroll
    for (int r = 0; r < 16; ++r) p1[r] = __builtin_amdgcn_exp2f(p1[r]);
    float ps = 0;
#pragma unroll
    for (int r = 0; r < 16; ++r) ps += p0[r];
#pragma unroll
    for (int r = 0; r < 16; ++r) ps += p1[r];
    { auto rr = __builtin_amdgcn_permlane32_swap(__float_as_uint(ps), __float_as_uint(ps), false, false); ps = __uint_as_float(rr[0]) + __uint_as_float(rr[1]); }
    l_reg = l_reg * alpha + ps;
#define PK4(P, BASE, OUT) do { unsigned a0 = cvtpk(P[BASE + 0], P[BASE + 1]), a1 = cvtpk(P[BASE + 2], P[BASE + 3]);   \
    unsigned b0 = cvtpk(P[BASE + 4], P[BASE + 5]), b1 = cvtpk(P[BASE + 6], P[BASE + 7]);                              \
    auto r0 = __builtin_amdgcn_permlane32_swap(a0, b0, false, false); auto r1 = __builtin_amdgcn_permlane32_swap(a1, b1, false, false); \
    u32x4 w = {r0[0], r1[0], r0[1], r1[1]}; OUT = *reinterpret_cast<bf16x8*>(&w); } while (0)
    PK4(p0, 0, pa0); PK4(p0, 8, pa1); PK4(p1, 0, pa2); PK4(p1, 8, pa3);
#undef PK4
}
template <bool BIAS, bool ADDREF>
__device__ __forceinline__ void partialSM_fix(f32x16& p0, f32x16& p1, const char* pkl, int hi, float pq, float cneg, float negref) {
    if constexpr (BIAS) {
#pragma unroll
        for (int i = 0; i < 4; ++i) {
            const f32x4 k0 = *(const f32x4*)(pkl + (8 * i + 4 * hi) * 4), k1 = *(const f32x4*)(pkl + (32 + 8 * i + 4 * hi) * 4);
#pragma unroll
            for (int j = 0; j < 4; ++j) { p0[4 * i + j] = fmaf(fabsf(pq - k0[j]), cneg, p0[4 * i + j]); p1[4 * i + j] = fmaf(fabsf(pq - k1[j]), cneg, p1[4 * i + j]); }
        }
    }
    if constexpr (ADDREF) {
#pragma unroll
        for (int r = 0; r < 16; ++r) { p0[r] += negref; p1[r] += negref; }
    }
#pragma unroll
    for (int r = 0; r < 16; ++r) p0[r] = __builtin_amdgcn_exp2f(p0[r]);
}
__device__ __forceinline__ void finishSM_fix(f32x16& p0, f32x16& p1, float& l_reg, bf16x8& pa0, bf16x8& pa1, bf16x8& pa2, bf16x8& pa3) {
#pragma unroll
    for (int r = 0; r < 16; ++r) p1[r] = __builtin_amdgcn_exp2f(p1[r]);
    float ps = 0;
#pragma unroll
    for (int r = 0; r < 16; ++r) ps += p0[r];
#pragma unroll
    for (int r = 0; r < 16; ++r) ps += p1[r];
    l_reg += ps;
#define PK4(P, BASE, OUT) do { unsigned a0 = cvtpk(P[BASE + 0], P[BASE + 1]), a1 = cvtpk(P[BASE + 2], P[BASE + 3]);   \
    unsigned b0 = cvtpk(P[BASE + 4], P[BASE + 5]), b1 = cvtpk(P[BASE + 6], P[BASE + 7]);                              \
    auto r0 = __builtin_amdgcn_permlane32_swap(a0, b0, false, false); auto r1 = __builtin_amdgcn_permlane32_swap(a1, b1, false, false); \
    u32x4 w = {r0[0], r1[0], r0[1], r1[1]}; OUT = *reinterpret_cast<bf16x8*>(&w); } while (0)
    PK4(p0, 0, pa0); PK4(p0, 8, pa1); PK4(p1, 0, pa2); PK4(p1, 8, pa3);
#undef PK4
}
template <bool HASKR>
__device__ __forceinline__ void qkt(f32x16& p0, f32x16& p1, const char* buf, const bf16x8* qr, int r32, int hi, const f32x16& cinit) {
    p0 = cinit; p1 = cinit;
    const char* kb = buf + KN_OFF + r32 * 144 + hi * 16;
#pragma unroll
    for (int d0 = 0; d0 < 4; ++d0) {
        const bf16x8 b0 = *reinterpret_cast<const bf16x8*>(kb + d0 * 32);
        const bf16x8 b1 = *reinterpret_cast<const bf16x8*>(kb + 32 * 144 + d0 * 32);
        p0 = __builtin_amdgcn_mfma_f32_32x32x16_bf16(b0, qr[d0], p0, 0, 0, 0);
        p1 = __builtin_amdgcn_mfma_f32_32x32x16_bf16(b1, qr[d0], p1, 0, 0, 0);
    }
    if constexpr (HASKR) {
        const char* kr = buf + KR_OFF + r32 * 80 + hi * 16;
#pragma unroll
        for (int d0 = 0; d0 < 2; ++d0) {
            const bf16x8 b0 = *reinterpret_cast<const bf16x8*>(kr + d0 * 32);
            const bf16x8 b1 = *reinterpret_cast<const bf16x8*>(kr + 32 * 80 + d0 * 32);
            p0 = __builtin_amdgcn_mfma_f32_32x32x16_bf16(b0, qr[4 + d0], p0, 0, 0, 0);
            p1 = __builtin_amdgcn_mfma_f32_32x32x16_bf16(b1, qr[4 + d0], p1, 0, 0, 0);
        }
    }
}
template <int DVB, int D0> __device__ __forceinline__ void pv_one(f32x16& od, int vb, bf16x8 pa0, bf16x8 pa1, bf16x8 pa2, bf16x8 pa3) {
    constexpr int KS = 2 * DVB * 512, HF = DVB * 512, B0 = D0 * 512;
    const s16x4 l0 = tr_read<B0>(vb), h0 = tr_read<B0 + HF>(vb), l1 = tr_read<B0 + KS>(vb), h1 = tr_read<B0 + KS + HF>(vb);
    const s16x4 l2 = tr_read<B0 + 2 * KS>(vb), h2 = tr_read<B0 + 2 * KS + HF>(vb), l3 = tr_read<B0 + 3 * KS>(vb), h3 = tr_read<B0 + 3 * KS + HF>(vb);
    asm volatile("s_waitcnt lgkmcnt(0)" ::: "memory"); SBAR();
#define PK(L, H) (bf16x8){L[0], L[1], L[2], L[3], H[0], H[1], H[2], H[3]}
    od = __builtin_amdgcn_mfma_f32_32x32x16_bf16(pa0, PK(l0, h0), od, 0, 0, 0);
    od = __builtin_amdgcn_mfma_f32_32x32x16_bf16(pa1, PK(l1, h1), od, 0, 0, 0);
    od = __builtin_amdgcn_mfma_f32_32x32x16_bf16(pa2, PK(l2, h2), od, 0, 0, 0);
    od = __builtin_amdgcn_mfma_f32_32x32x16_bf16(pa3, PK(l3, h3), od, 0, 0, 0);
#undef PK
}
template <int DVB> __device__ __forceinline__ void pv_all(f32x16* o, int vb, bf16x8 pa0, bf16x8 pa1, bf16x8 pa2, bf16x8 pa3) {
    pv_one<DVB, 0>(o[0], vb, pa0, pa1, pa2, pa3); pv_one<DVB, 1>(o[1], vb, pa0, pa1, pa2, pa3);
    if constexpr (DVB == 4) { pv_one<DVB, 2>(o[2], vb, pa0, pa1, pa2, pa3); pv_one<DVB, 3>(o[3], vb, pa0, pa1, pa2, pa3); }
}

template <int DVB, bool HASKR, bool BIAS, int SD, bool FIX, bool CINIT>
__device__ __forceinline__ void attn_pass(const bf16* __restrict__ Qrow, const bf16* __restrict__ Kn, int ldk, const bf16* __restrict__ Kr,
                                          const bf16* __restrict__ Vh, int ldv, const int* __restrict__ posk, float pq, float cneg, char* lds, f32x16 (&o)[DVB], const int tid, const int t0, const int NT, const float negref) {
    constexpr int DQB = HASKR ? 6 : 4;
    const int wid = tid >> 6, lane = tid & 63, r32 = lane & 31, hi = lane >> 5;
    float* wsf = (float*)(lds + WSF_OFF) + wid * 64; float* li_l = wsf; float* al_l = wsf + 32;
    float m_reg = -1e30f, l_reg = 0.f;
#pragma unroll
    for (int d = 0; d < DVB; ++d) o[d] = f32x16{};
    bf16x8 qr[DQB];
#pragma unroll
    for (int d0 = 0; d0 < DQB; ++d0) qr[d0] = *reinterpret_cast<const bf16x8*>(Qrow + d0 * 16);
    const int kn_r = tid >> 3, kn_c = (tid & 7) * 8, kn_st = kn_r * 144 + kn_c * 2;
    const int kr_r = (tid >> 2) & 63, kr_c = (tid & 3) * 8, kr_st = kr_r * 80 + kr_c * 2;
    const int v4_r = tid >> 4, v4_c = (tid & 15) * 8;
    const int vst0 = (DVB == 2) ? v_st<DVB>(kn_r, kn_c) : v_st<DVB>(v4_r, v4_c), vst1 = (DVB == 2) ? 0 : v_st<DVB>(32 + v4_r, v4_c);
    const int vb0 = (int)(uintptr_t)(lds + V_OFF) + v_rd_base(lane);
    struct Slot { bf16x8 kn, kr, v0, v1; float pk; } sr_[SD];
#define SLOAD(i, k0) do { sr_[i].kn = *reinterpret_cast<const bf16x8*>(Kn + (size_t)((k0) + kn_r) * ldk + kn_c); \
    if constexpr (HASKR) sr_[i].kr = *reinterpret_cast<const bf16x8*>(Kr + (size_t)((k0) + kr_r) * 32 + kr_c); \
    if constexpr (DVB == 2) sr_[i].v0 = *reinterpret_cast<const bf16x8*>(Vh + (size_t)((k0) + kn_r) * ldv + kn_c); \
    else { sr_[i].v0 = *reinterpret_cast<const bf16x8*>(Vh + (size_t)((k0) + v4_r) * ldv + v4_c); sr_[i].v1 = *reinterpret_cast<const bf16x8*>(Vh + (size_t)((k0) + 32 + v4_r) * ldv + v4_c); } \
    if constexpr (BIAS) sr_[i].pk = (float)posk[(k0) + (tid & 63)]; } while (0)
#define SWRITE(boff, i) do { char* bb_ = lds + (boff); *reinterpret_cast<bf16x8*>(bb_ + KN_OFF + kn_st) = sr_[i].kn; \
    if constexpr (HASKR) { if (tid < 256) *reinterpret_cast<bf16x8*>(bb_ + KR_OFF + kr_st) = sr_[i].kr; } \
    *reinterpret_cast<bf16x8*>(bb_ + V_OFF + vst0) = sr_[i].v0; \
    if constexpr (DVB == 4) *reinterpret_cast<bf16x8*>(bb_ + V_OFF + vst1) = sr_[i].v1; \
    if constexpr (BIAS) { if (tid < 64) *reinterpret_cast<float*>(bb_ + PK_OFF + tid * 4) = sr_[i].pk; } } while (0)
#define RESC(a) do { if (__any((a) < 1.f)) { if (hi == 0) al_l[r32] = (a); asm volatile("s_waitcnt lgkmcnt(0)" ::: "memory"); \
    _Pragma("unroll") for (int d = 0; d < DVB; ++d) _Pragma("unroll") for (int r = 0; r < 16; ++r) o[d][r] *= al_l[crow(r, hi)]; } } while (0)
    f32x16 pA0, pA1, pB0, pB1; float alA = 1.f, alB = 1.f; bf16x8 pa0, pa1, pa2, pa3;
    f32x16 cinit = f32x16{};
    if constexpr (FIX && CINIT) {
#pragma unroll
        for (int r = 0; r < 16; ++r) cinit[r] = negref;
        asm volatile("" : "+v"(cinit));
    }
#define SMP(P0, P1, AL, BUFP) do { if constexpr (FIX) partialSM_fix<BIAS, !CINIT>(P0, P1, (BUFP) + PK_OFF, hi, pq, cneg, negref); else partialSM<BIAS>(P0, P1, m_reg, AL, (BUFP) + PK_OFF, hi, pq, cneg); } while (0)
#define SMF(P0, P1, AL) do { if constexpr (FIX) finishSM_fix(P0, P1, l_reg, pa0, pa1, pa2, pa3); else finishSM(P0, P1, AL, l_reg, pa0, pa1, pa2, pa3); } while (0)
#define RESCX(AL) do { if constexpr (!FIX) RESC(AL); } while (0)
    int oV = 0, oK = BUF, oW = 2 * BUF;
#define ROT() do { const int t_ = oV; oV = oK; oK = oW; oW = t_; } while (0)
#define ITER(PX0, PX1, ALX, PY0, PY1, ALY, i, PAR) do { \
        SBAR(); qkt<HASKR>(PY0, PY1, lds + oK, qr, r32, hi, cinit); SMF(PX0, PX1, ALX); SBAR(); \
        if constexpr (SD == 2) { if ((i) + 3 < NT) SLOAD(1 - (PAR), (t0 + (i) + 3) * 64); } else { if ((i) + 2 < NT) SLOAD(0, (t0 + (i) + 2) * 64); } SBAR(); \
        pv_all<DVB>(o, vb0 + oV, pa0, pa1, pa2, pa3); SMP(PY0, PY1, ALY, lds + oK); RESCX(ALY); \
        if ((i) + 2 < NT) SWRITE(oW, (SD == 2) ? (PAR) : 0); \
        __syncthreads(); ROT(); } while (0)
    SLOAD(0, t0 * 64); SWRITE(0, 0);
    SLOAD(SD - 1, (t0 + 1) * 64); SWRITE(BUF, SD - 1);
    if constexpr (SD == 2) if (2 < NT) SLOAD(0, (t0 + 2) * 64);
    __syncthreads();
    qkt<HASKR>(pA0, pA1, lds, qr, r32, hi, cinit); SMP(pA0, pA1, alA, lds); RESCX(alA);
    for (int i = 0; i + 2 < NT; i += 2) {
        ITER(pA0, pA1, alA, pB0, pB1, alB, i, 0);
        ITER(pB0, pB1, alB, pA0, pA1, alA, i + 1, 1);
    }
    ITER(pA0, pA1, alA, pB0, pB1, alB, NT - 2, 0);
    SMF(pB0, pB1, alB); SBAR();
    pv_all<DVB>(o, vb0 + oV, pa0, pa1, pa2, pa3);
#undef ITER
#undef ROT
    if constexpr (FIX) l_reg = add_xor32(l_reg);
    if (hi == 0) li_l[r32] = l_reg; asm volatile("s_waitcnt lgkmcnt(0)" ::: "memory");
#pragma unroll
    for (int r = 0; r < 16; ++r) { const float rl = __builtin_amdgcn_rcpf(li_l[crow(r, hi)]);
#pragma unroll
        for (int d = 0; d < DVB; ++d) o[d][r] *= rl; }
    __syncthreads();
#undef SLOAD
#undef SWRITE
#undef RESC
#undef SMP
#undef SMF
#undef RESCX
}

__device__ __forceinline__ void attn_mla2(const bf16* __restrict__ Q0, const bf16* __restrict__ Q1, const bf16* __restrict__ Kn, const bf16* __restrict__ Kr, const bf16* __restrict__ Vh,
                                          char* lds, f32x16 (&o)[2][2], const int tid, const float nr0, const float nr1) {
    const int wid = tid >> 6, lane = tid & 63, r32 = lane & 31, hi = lane >> 5;
    float* wsf = (float*)(lds + WSF_OFF) + wid * 64;
    float l0 = 0.f, l1 = 0.f;
#pragma unroll
    for (int rb = 0; rb < 2; ++rb)
#pragma unroll
        for (int d = 0; d < 2; ++d) o[rb][d] = f32x16{};
    bf16x8 q0[6], q1[6];
#pragma unroll
    for (int d0 = 0; d0 < 6; ++d0) { q0[d0] = *reinterpret_cast<const bf16x8*>(Q0 + d0 * 16); q1[d0] = *reinterpret_cast<const bf16x8*>(Q1 + d0 * 16); }
    const int kn_r = tid >> 3, kn_c = (tid & 7) * 8, kn_st = kn_r * 144 + kn_c * 2;
    const int kr_r = (tid >> 2) & 63, kr_c = (tid & 3) * 8, kr_st = kr_r * 80 + kr_c * 2;
    const int vst0 = v_st<2>(kn_r, kn_c);
    const int vb0 = (int)(uintptr_t)(lds + V_OFF) + v_rd_base(lane);
    bf16x8 s_kn, s_kr, s_v;
#define SLOAD2(k0) do { s_kn = *reinterpret_cast<const bf16x8*>(Kn + (size_t)((k0) + kn_r) * 1024 + kn_c); s_kr = *reinterpret_cast<const bf16x8*>(Kr + (size_t)((k0) + kr_r) * 32 + kr_c); \
    s_v = *reinterpret_cast<const bf16x8*>(Vh + (size_t)((k0) + kn_r) * 1024 + kn_c); } while (0)
#define SWRITE2(boff) do { char* bb_ = lds + (boff); *reinterpret_cast<bf16x8*>(bb_ + KN_OFF + kn_st) = s_kn; if (tid < 256) *reinterpret_cast<bf16x8*>(bb_ + KR_OFF + kr_st) = s_kr; \
    *reinterpret_cast<bf16x8*>(bb_ + V_OFF + vst0) = s_v; } while (0)
#define PK4(P, BASE, OUT) do { unsigned a0 = cvtpk(P[BASE + 0], P[BASE + 1]), a1 = cvtpk(P[BASE + 2], P[BASE + 3]);   \
    unsigned b0 = cvtpk(P[BASE + 4], P[BASE + 5]), b1 = cvtpk(P[BASE + 6], P[BASE + 7]);                              \
    auto r0 = __builtin_amdgcn_permlane32_swap(a0, b0, false, false); auto r1 = __builtin_amdgcn_permlane32_swap(a1, b1, false, false); \
    u32x4 w = {r0[0], r1[0], r0[1], r1[1]}; OUT = *reinterpret_cast<bf16x8*>(&w); } while (0)
    constexpr int NT = SEQ / 64;
    SLOAD2(0); SWRITE2(0); __syncthreads();
    int cur = 0;
    for (int t = 0; t < NT; ++t) {
        const char* buf = lds + cur;
        f32x16 pa0 = f32x16{}, pa1 = f32x16{}, pb0 = f32x16{}, pb1 = f32x16{};
        {
            const char* kb = buf + KN_OFF + r32 * 144 + hi * 16; const char* kr = buf + KR_OFF + r32 * 80 + hi * 16;
#define KLD0(D0) ((D0) < 4 ? *reinterpret_cast<const bf16x8*>(kb + (D0) * 32) : *reinterpret_cast<const bf16x8*>(kr + ((D0) - 4) * 32))
#define KLD1(D0) ((D0) < 4 ? *reinterpret_cast<const bf16x8*>(kb + 32 * 144 + (D0) * 32) : *reinterpret_cast<const bf16x8*>(kr + 32 * 80 + ((D0) - 4) * 32))
            bf16x8 c0 = KLD0(0), c1 = KLD1(0);
#pragma unroll
            for (int d0 = 0; d0 < 6; ++d0) {
                bf16x8 n0 = c0, n1 = c1;
                if (d0 + 1 < 6) { n0 = KLD0(d0 + 1); n1 = KLD1(d0 + 1); }
                pa0 = __builtin_amdgcn_mfma_f32_32x32x16_bf16(c0, q0[d0], pa0, 0, 0, 0); pb0 = __builtin_amdgcn_mfma_f32_32x32x16_bf16(c0, q1[d0], pb0, 0, 0, 0);
                pa1 = __builtin_amdgcn_mfma_f32_32x32x16_bf16(c1, q0[d0], pa1, 0, 0, 0); pb1 = __builtin_amdgcn_mfma_f32_32x32x16_bf16(c1, q1[d0], pb1, 0, 0, 0);
                SBAR(); c0 = n0; c1 = n1;
            }
#undef KLD0
#undef KLD1
        }
        if (t + 1 < NT) SLOAD2((t + 1) * 64);
        bf16x8 fa0, fa1, fa2, fa3, fb0, fb1, fb2, fb3;
        {   float ps = 0.f;
#pragma unroll
            for (int r = 0; r < 16; ++r) { pa0[r] = __builtin_amdgcn_exp2f(pa0[r]); pa1[r] = __builtin_amdgcn_exp2f(pa1[r]);     ps += pa0[r] + pa1[r]; }
            l0 += ps; PK4(pa0, 0, fa0); PK4(pa0, 8, fa1); PK4(pa1, 0, fa2); PK4(pa1, 8, fa3); }
        {   float ps = 0.f;
#pragma unroll
            for (int r = 0; r < 16; ++r) { pb0[r] = __builtin_amdgcn_exp2f(pb0[r]); pb1[r] = __builtin_amdgcn_exp2f(pb1[r]); ps += pb0[r] + pb1[r]; }
            l1 += ps; PK4(pb0, 0, fb0); PK4(pb0, 8, fb1); PK4(pb1, 0, fb2); PK4(pb1, 8, fb3); }
        {   const int vb = vb0 + cur;
#define PV2(D0) do { constexpr int KS = 2 * 2 * 512, HF = 2 * 512, B0 = (D0) * 512; \
            const s16x4 l0_ = tr_read<B0>(vb), h0_ = tr_read<B0 + HF>(vb), l1_ = tr_read<B0 + KS>(vb), h1_ = tr_read<B0 + KS + HF>(vb); \
            const s16x4 l2_ = tr_read<B0 + 2 * KS>(vb), h2_ = tr_read<B0 + 2 * KS + HF>(vb), l3_ = tr_read<B0 + 3 * KS>(vb), h3_ = tr_read<B0 + 3 * KS + HF>(vb); \
            asm volatile("s_waitcnt lgkmcnt(0)" ::: "memory"); SBAR(); \
            const bf16x8 v0_ = (bf16x8){l0_[0], l0_[1], l0_[2], l0_[3], h0_[0], h0_[1], h0_[2], h0_[3]}, v1_ = (bf16x8){l1_[0], l1_[1], l1_[2], l1_[3], h1_[0], h1_[1], h1_[2], h1_[3]}; \
            const bf16x8 v2_ = (bf16x8){l2_[0], l2_[1], l2_[2], l2_[3], h2_[0], h2_[1], h2_[2], h2_[3]}, v3_ = (bf16x8){l3_[0], l3_[1], l3_[2], l3_[3], h3_[0], h3_[1], h3_[2], h3_[3]}; \
            o[0][D0] = __builtin_amdgcn_mfma_f32_32x32x16_bf16(fa0, v0_, o[0][D0], 0, 0, 0); o[1][D0] = __builtin_amdgcn_mfma_f32_32x32x16_bf16(fb0, v0_, o[1][D0], 0, 0, 0); \
            o[0][D0] = __builtin_amdgcn_mfma_f32_32x32x16_bf16(fa1, v1_, o[0][D0], 0, 0, 0); o[1][D0] = __builtin_amdgcn_mfma_f32_32x32x16_bf16(fb1, v1_, o[1][D0], 0, 0, 0); \
            o[0][D0] = __builtin_amdgcn_mfma_f32_32x32x16_bf16(fa2, v2_, o[0][D0], 0, 0, 0); o[1][D0] = __builtin_amdgcn_mfma_f32_32x32x16_bf16(fb2, v2_, o[1][D0], 0, 0, 0); \
            o[0][D0] = __builtin_amdgcn_mfma_f32_32x32x16_bf16(fa3, v3_, o[0][D0], 0, 0, 0); o[1][D0] = __builtin_amdgcn_mfma_f32_32x32x16_bf16(fb3, v3_, o[1][D0], 0, 0, 0); } while (0)
            PV2(0); PV2(1);
#undef PV2
        }
        if (t + 1 < NT) {
            int tw = tid; asm volatile("" : "+v"(tw));
            char* bb_ = lds + (BUF - cur);
            *reinterpret_cast<bf16x8*>(bb_ + KN_OFF + (tw >> 3) * 144 + (tw & 7) * 16) = s_kn;
            if (tw < 256) *reinterpret_cast<bf16x8*>(bb_ + KR_OFF + ((tw >> 2) & 63) * 80 + (tw & 3) * 16) = s_kr;
            *reinterpret_cast<bf16x8*>(bb_ + V_OFF + v_st<2>(tw >> 3, (tw & 7) * 8)) = s_v;
        }
        __syncthreads();
        cur = BUF - cur;
    }
    l0 = add_xor32(l0); l1 = add_xor32(l1);
    if (hi == 0) { wsf[r32] = l0; wsf[32 + r32] = l1; } asm volatile("s_waitcnt lgkmcnt(0)" ::: "memory");
#pragma unroll
    for (int r = 0; r < 16; ++r) { const float ra = __builtin_amdgcn_rcpf(wsf[crow(r, hi)]), rb = __builtin_amdgcn_rcpf(wsf[32 + crow(r, hi)]);
#pragma unroll
        for (int d = 0; d < 2; ++d) { o[0][d][r] *= ra; o[1][d][r] *= rb; } }
    __syncthreads();
#undef SLOAD2
#undef SWRITE2
#undef PK4
}
__device__ __forceinline__ void attn_diff1(const bf16* __restrict__ Qrow, const bf16* __restrict__ Kn, const bf16* __restrict__ Vh, const int* __restrict__ posk, const float pq, const float cneg,
                                           char* lds, f32x16 (&o)[4], const int tid, const int t0, const int NT, const float negref) {
    const int wid = tid >> 6, lane = tid & 63, r32 = lane & 31, hi = lane >> 5;
    float* wsf = (float*)(lds + WSF_OFF) + wid * 64;
    float l_reg = 0.f;
#pragma unroll
    for (int d = 0; d < 4; ++d) o[d] = f32x16{};
    bf16x8 qr[4];
#pragma unroll
    for (int d0 = 0; d0 < 4; ++d0) qr[d0] = *reinterpret_cast<const bf16x8*>(Qrow + d0 * 16);
    const int kn_r = tid >> 3, kn_c = (tid & 7) * 8, kn_st = kn_r * 144 + kn_c * 2;
    const int v4_r = tid >> 4, v4_c = (tid & 15) * 8;
    const int vst0 = v_st<4>(v4_r, v4_c), vst1 = v_st<4>(32 + v4_r, v4_c);
    const int vb0 = (int)(uintptr_t)(lds + V_OFF) + v_rd_base(lane);
    bf16x8 s_kn, s_v0, s_v1; float s_pk;
#define SLOADD(k0) do { s_kn = *reinterpret_cast<const bf16x8*>(Kn + (size_t)((k0) + kn_r) * 1024 + kn_c); s_v0 = *reinterpret_cast<const bf16x8*>(Vh + (size_t)((k0) + v4_r) * 1024 + v4_c); \
    s_v1 = *reinterpret_cast<const bf16x8*>(Vh + (size_t)((k0) + 32 + v4_r) * 1024 + v4_c); s_pk = (float)posk[(k0) + (tid & 63)]; } while (0)
#define SWRITED(boff) do { char* bb_ = lds + (boff); *reinterpret_cast<bf16x8*>(bb_ + KN_OFF + kn_st) = s_kn; *reinterpret_cast<bf16x8*>(bb_ + V_OFF + vst0) = s_v0; \
    *reinterpret_cast<bf16x8*>(bb_ + V_OFF + vst1) = s_v1; if (tid < 64) *reinterpret_cast<float*>(bb_ + PK_OFF + tid * 4) = s_pk; } while (0)
#define PK4(P, BASE, OUT) do { unsigned a0 = cvtpk(P[BASE + 0], P[BASE + 1]), a1 = cvtpk(P[BASE + 2], P[BASE + 3]);   \
    unsigned b0 = cvtpk(P[BASE + 4], P[BASE + 5]), b1 = cvtpk(P[BASE + 6], P[BASE + 7]);                              \
    auto r0 = __builtin_amdgcn_permlane32_swap(a0, b0, false, false); auto r1 = __builtin_amdgcn_permlane32_swap(a1, b1, false, false); \
    u32x4 w = {r0[0], r1[0], r0[1], r1[1]}; OUT = *reinterpret_cast<bf16x8*>(&w); } while (0)
    SLOADD(t0 * 64); SWRITED(0); __syncthreads();
    int cur = 0;
    for (int t = 0; t < NT; ++t) {
        const char* buf = lds + cur;
        f32x16 p0 = f32x16{}, p1 = f32x16{};
        {   const char* kb = buf + KN_OFF + r32 * 144 + hi * 16;
            bf16x8 c0 = *reinterpret_cast<const bf16x8*>(kb), c1 = *reinterpret_cast<const bf16x8*>(kb + 32 * 144);
#pragma unroll
            for (int d0 = 0; d0 < 4; ++d0) {
                bf16x8 n0 = c0, n1 = c1;
                if (d0 + 1 < 4) { n0 = *reinterpret_cast<const bf16x8*>(kb + (d0 + 1) * 32); n1 = *reinterpret_cast<const bf16x8*>(kb + 32 * 144 + (d0 + 1) * 32); }
                p0 = __builtin_amdgcn_mfma_f32_32x32x16_bf16(c0, qr[d0], p0, 0, 0, 0); p1 = __builtin_amdgcn_mfma_f32_32x32x16_bf16(c1, qr[d0], p1, 0, 0, 0);
                c0 = n0; c1 = n1;
            }
        }
        if (t + 1 < NT) SLOADD((t0 + t + 1) * 64);
        const int vb = vb0 + cur;
#define VRD(D0, L, H) do { constexpr int KS = 2 * 4 * 512, HF = 4 * 512, B0 = (D0) * 512; \
            L[0] = tr_read<B0>(vb); H[0] = tr_read<B0 + HF>(vb); L[1] = tr_read<B0 + KS>(vb); H[1] = tr_read<B0 + KS + HF>(vb); \
            L[2] = tr_read<B0 + 2 * KS>(vb); H[2] = tr_read<B0 + 2 * KS + HF>(vb); L[3] = tr_read<B0 + 3 * KS>(vb); H[3] = tr_read<B0 + 3 * KS + HF>(vb); } while (0)
#define VFR(L, H, k) (bf16x8){L[k][0], L[k][1], L[k][2], L[k][3], H[k][0], H[k][1], H[k][2], H[k][3]}
#define PVM(D0, L, H) do { o[D0] = __builtin_amdgcn_mfma_f32_32x32x16_bf16(fa0, VFR(L, H, 0), o[D0], 0, 0, 0); o[D0] = __builtin_amdgcn_mfma_f32_32x32x16_bf16(fa1, VFR(L, H, 1), o[D0], 0, 0, 0); \
            o[D0] = __builtin_amdgcn_mfma_f32_32x32x16_bf16(fa2, VFR(L, H, 2), o[D0], 0, 0, 0); o[D0] = __builtin_amdgcn_mfma_f32_32x32x16_bf16(fa3, VFR(L, H, 3), o[D0], 0, 0, 0); } while (0)
        s16x4 la[4], ha[4], lb[4], hb[4];
        VRD(0, la, ha); VRD(1, lb, hb);
        {   const char* pkl = buf + PK_OFF;
#pragma unroll
            for (int i = 0; i < 4; ++i) {
                const f32x4 k0 = *(const f32x4*)(pkl + (8 * i + 4 * hi) * 4), k1 = *(const f32x4*)(pkl + (32 + 8 * i + 4 * hi) * 4);
#pragma unroll
                for (int q = 0; q < 4; ++q) { p0[4 * i + q] = fmaf(fabsf(pq - k0[q]), cneg, p0[4 * i + q]); p1[4 * i + q] = fmaf(fabsf(pq - k1[q]), cneg, p1[4 * i + q]); }
            }
        }
        bf16x8 fa0, fa1, fa2, fa3;
        {   float ps = 0.f;
#pragma unroll
            for (int r = 0; r < 16; ++r) { p0[r] = __builtin_amdgcn_exp2f(p0[r]); p1[r] = __builtin_amdgcn_exp2f(p1[r]);     ps += p0[r] + p1[r]; }
            l_reg += ps; PK4(p0, 0, fa0); PK4(p0, 8, fa1); PK4(p1, 0, fa2); PK4(p1, 8, fa3); }
        asm volatile("s_waitcnt lgkmcnt(0)" ::: "memory"); SBAR();
        PVM(0, la, ha); SBAR();
        VRD(2, la, ha);
        SBAR(); PVM(1, lb, hb); SBAR();
        VRD(3, lb, hb);
        asm volatile("s_waitcnt lgkmcnt(8)" ::: "memory"); SBAR();
        PVM(2, la, ha);
        asm volatile("s_waitcnt lgkmcnt(0)" ::: "memory"); SBAR();
        PVM(3, lb, hb);
#undef VRD
#undef VFR
#undef PVM
        if (t + 1 < NT) SWRITED(BUF - cur);
        __syncthreads();
        cur = BUF - cur;
    }
    l_reg = add_xor32(l_reg);
    if (hi == 0) wsf[r32] = l_reg; asm volatile("s_waitcnt lgkmcnt(0)" ::: "memory");
#pragma unroll
    for (int r = 0; r < 16; ++r) { const float rl = __builtin_amdgcn_rcpf(wsf[crow(r, hi)]);
#pragma unroll
        for (int d = 0; d < 4; ++d) o[d][r] *= rl; }
    __syncthreads();
#undef SLOADD
#undef SWRITED
#undef PK4
}
}

#define XB_TMO      128
#define XB_XCNT(j)  (256  + 64 * (j))
#define XB_XSUB(j)  (1280 + 64 * (j))
#define XB_XGEN(j)  (2304 + 64 * (j))
#define XB_TOP      3328
#define XB_TOPGEN   3392
#define XCD_BAR_WORDS 3456
#define XB_SPIN_CAP (1u << 18)

__device__ __forceinline__ unsigned xb_ld(unsigned* p)              { return __hip_atomic_load(p, __ATOMIC_RELAXED, __HIP_MEMORY_SCOPE_AGENT); }
__device__ __forceinline__ unsigned xb_add(unsigned* p, unsigned v) { return __hip_atomic_fetch_add(p, v, __ATOMIC_RELAXED, __HIP_MEMORY_SCOPE_AGENT); }
__device__ __forceinline__ unsigned xb_xcc_id() { return (unsigned)__builtin_amdgcn_s_getreg((3 << 11) | 20) & 0xFu; }
#define XB_SPIN(cond, bar) do { unsigned _sp = 0; while (cond) { __builtin_amdgcn_s_sleep(1); \
    if ((++_sp & 255u) == 0u) { if (xb_ld(&(bar)[XB_TMO])) break; if (_sp > XB_SPIN_CAP) { atomicAdd(&(bar)[XB_TMO], 1u); break; } } } } while (0)

struct XcdBarrier {
    unsigned* bar; unsigned x;
    volatile LAS unsigned* st;
};

__device__ __forceinline__ XcdBarrier xcd_barrier_post(unsigned* bar, volatile LAS unsigned* st) {
    XcdBarrier b; b.bar = bar; b.x = xb_xcc_id(); b.st = st;
    if (threadIdx.x == 0) (void)xb_add(&bar[XB_XCNT(b.x)], 1u);
    return b;
}
__device__ __forceinline__ void xcd_barrier_complete(unsigned* bar, unsigned x, unsigned& nloc, unsigned& nx) {
    const unsigned G = gridDim.x * gridDim.y * gridDim.z;
    unsigned sum, cnt, mine, sp = 0u;
    for (;;) {
        sum = 0u; cnt = 0u; mine = 0u;
#pragma unroll
        for (unsigned j = 0; j < 16; ++j) { const unsigned c = xb_ld(&bar[XB_XCNT(j)]); sum += c; cnt += (c > 0u) ? 1u : 0u; mine = (j == x) ? c : mine; }
        if (sum == G) break;
        __builtin_amdgcn_s_sleep(1);
        if ((++sp & 255u) == 0u) { if (xb_ld(&bar[XB_TMO])) break; if (sp > XB_SPIN_CAP) { atomicAdd(&bar[XB_TMO], 1u); break; } }
    }
    nloc = mine > 0u ? mine : 1u; nx = cnt > 0u ? cnt : 1u;
}

__device__ __forceinline__ void xcd_barrier(const XcdBarrier& b) {
    asm volatile("s_waitcnt vmcnt(0)" ::: "memory");
    __syncthreads();
    if (threadIdx.x == 0) {
        unsigned* bar = b.bar;
        __builtin_amdgcn_s_waitcnt(0);
        unsigned nloc = b.st[0], nx = b.st[1];
        if (nloc == 0u) { xcd_barrier_complete(bar, b.x, nloc, nx); b.st[0] = nloc; b.st[1] = nx; }
        const unsigned old = xb_add(&bar[XB_XSUB(b.x)], 1u);
        const unsigned gen = old / nloc;
        if (old + 1u == (gen + 1u) * nloc) {
            __builtin_amdgcn_fence(__ATOMIC_RELEASE, "agent");
            asm volatile("s_waitcnt vmcnt(0)" ::: "memory");
            const unsigned og = xb_add(&bar[XB_TOP], 1u);
            const unsigned tg = og / nx;
            if (og + 1u == (tg + 1u) * nx) xb_add(&bar[XB_TOPGEN], 1u);
            else XB_SPIN(xb_ld(&bar[XB_TOPGEN]) == tg, bar);
            __builtin_amdgcn_fence(__ATOMIC_ACQUIRE, "agent");
            xb_add(&bar[XB_XGEN(b.x)], 1u);
            asm volatile("s_waitcnt vmcnt(0)" ::: "memory");
        } else {
            XB_SPIN(xb_ld(&bar[XB_XGEN(b.x)]) == gen, bar);
            __builtin_amdgcn_fence(__ATOMIC_ACQUIRE, "agent");
            asm volatile("s_waitcnt vmcnt(0)" ::: "memory");
        }
    }
    __syncthreads();
}

struct Args {
    const float* x; const float* c; const int* pos; const float* ada_w; const float* ada_b; const float* norm_g;
    const float* mla_w_in; const float* mla_qg; const float* mla_wq; const float* mla_kvg; const float* mla_wkv; const float* mla_wo;
    const float* diff_w_in; const float* lq1; const float* lk1; const float* lq2; const float* lk2; const float* head_g; const float* diff_wo; const float* final_g;
    float* out; unsigned char* ws;
};

__device__ __forceinline__ unsigned f2bf(float f) { unsigned u = __builtin_bit_cast(unsigned, f); return (u + 0x7fffu + ((u >> 16) & 1u)) >> 16; }
__device__ __forceinline__ unsigned pk2(float lo, float hi) { return f2bf(lo) | (f2bf(hi) << 16); }

__device__ __forceinline__ void transpose_item(const float* W, const float* gain, int K, int N, bf16* WT, LAS float* scr, int item, int lane) {
    const int nblk = N / 32, kb = item / nblk, nb = item % nblk, k0 = 64 * kb, n0 = 32 * nb;
    f32x4 wv[8];
#pragma unroll
    for (int i = 0; i < 8; ++i) wv[i] = *(const f32x4*)(W + (size_t)(k0 + 8 * i + (lane >> 3)) * N + n0 + (lane & 7) * 4);
#pragma unroll
    for (int i = 0; i < 8; ++i) { const int kk = 8 * i + (lane >> 3); f32x4 w = wv[i]; if (gain) w = w * gain[k0 + kk]; LAS float* d = scr + kk * 33 + (lane & 7) * 4; d[0] = w[0]; d[1] = w[1]; d[2] = w[2]; d[3] = w[3]; }
    asm volatile("s_waitcnt lgkmcnt(0)" ::: "memory");
    const int c = lane & 7;
#pragma unroll
    for (int j = 0; j < 4; ++j) { const int n = (lane >> 3) + 8 * j; const LAS float* s = scr + (8 * c) * 33 + n;
        u32x4 o; o.x = pk2(s[0 * 33], s[1 * 33]); o.y = pk2(s[2 * 33], s[3 * 33]); o.z = pk2(s[4 * 33], s[5 * 33]); o.w = pk2(s[6 * 33], s[7 * 33]);
        *(u32x4*)(WT + (size_t)(n0 + n) * K + k0 + 8 * c) = o; }
    asm volatile("s_waitcnt lgkmcnt(0)" ::: "memory");
}

template <class F>
__device__ __forceinline__ void run_gemm(LAS unsigned char* lds, const bf16* A, int lda, const bf16* Bt, int N, int K, const F& f, const int tid, const int bxp, const int Gp) {
    pg8::Gemm g{A, Bt, M, N, K, lda}; pg8::StaticOrder S; S.init(M, N, Gp, bxp);
    pg8::EpiF<F> E{f};
    pg8::gemm_phase<pg8::EpiF<F>, pg8::StaticOrder, true, true>(lds, g, S, E, tid);
}

typedef const __attribute__((address_space(4))) Args KArgs;
__global__ void __launch_bounds__(512, 2) fwd_kernel(Args a) {
    extern __shared__ __attribute__((aligned(16))) unsigned char lds[];
    cg::grid_group grid = cg::this_grid();
    LAS unsigned char* ldsl = (LAS unsigned char*)lds;
    volatile LAS unsigned* bar_st = (volatile LAS unsigned*)(ldsl + 131072 + 64);
    if (threadIdx.x == 0) { bar_st[0] = 0u; bar_st[1] = 0u; }
    __syncthreads();
    const int tid = threadIdx.x, lane = tid & 63, wave = __builtin_amdgcn_readfirstlane(tid >> 6);
    const int G = gridDim.x, bx = blockIdx.x;
    const int vcu = (G % 8 == 0) ? (bx % 8) * (G / 8) + bx / 8 : bx;
    const int gw = bx * 8 + wave, ngw = G * 8;
    unsigned char* ws = a.ws;
    float* MOD = (float*)(ws + WS_MOD); float* PAR = (float*)(ws + WS_PAR); float* SSQ = (float*)(ws + WS_SSQ);
    float* RC = (float*)(ws + WS_COS); float* RS = (float*)(ws + WS_SIN);

    if (bx < 192) {
        float* cact = (float*)lds; float* red = (float*)lds + 2048;
        for (int i = tid; i < 2048; i += 512) cact[i] = silu1(a.c[i]);
        __syncthreads();
        const int l = bx / 48, cgp = bx % 48, col = tid & 63, kg = tid >> 6;
        const float* wp = a.ada_w + (size_t)l * 1024 * 3072 + (size_t)(kg * 128) * 3072 + cgp * 64 + col;
        float acc0 = 0.f, acc1 = 0.f;
#pragma unroll 16
        for (int k = 0; k < 128; ++k) { const float w = wp[(size_t)k * 3072]; acc0 = fmaf(cact[kg * 128 + k], w, acc0); acc1 = fmaf(cact[1024 + kg * 128 + k], w, acc1); }
        red[(kg * 2 + 0) * 64 + col] = acc0; red[(kg * 2 + 1) * 64 + col] = acc1;
        __syncthreads();
        if (tid < 128) { const int b = tid >> 6; float s = 0.f;
#pragma unroll
            for (int q = 0; q < 8; ++q) s += red[(q * 2 + b) * 64 + col];
            MOD[(l * 2 + b) * 3072 + cgp * 64 + col] = s + a.ada_b[l * 3072 + cgp * 64 + col]; }
        __syncthreads();
    }
    {
        LAS float* scr = (LAS float*)(ldsl + wave * 8448);
        constexpr int I_MIN = 16 * 53, I_MQ = 6 * 48, I_MKV = 4 * 64, I_O = 16 * 32, I_DIN = 16 * 128;
        constexpr int PER_J = I_MIN + I_MQ + I_MKV + I_O + I_DIN + I_O, NITEMS = 2 * PER_J;
        for (int it = gw; it < NITEMS; it += ngw) {
            const int j = it / PER_J; int r = it % PER_J;
            unsigned char* wm = ws + WS_WMLA + (size_t)j * W_MLA_SZ; unsigned char* wd = ws + WS_WDIFF + (size_t)j * W_DIFF_SZ;
            if (r < I_MIN) { transpose_item(a.mla_w_in + (size_t)j * 1024 * MLA_IN, nullptr, 1024, MLA_IN, (bf16*)(wm + W_MLA_IN), scr, r, lane); continue; } r -= I_MIN;
            if (r < I_MQ) { transpose_item(a.mla_wq + (size_t)j * 384 * 1536, a.mla_qg + j * 384, 384, 1536, (bf16*)(wm + W_MLA_Q), scr, r, lane); continue; } r -= I_MQ;
            if (r < I_MKV) { transpose_item(a.mla_wkv + (size_t)j * 256 * 2048, a.mla_kvg + j * 256, 256, 2048, (bf16*)(wm + W_MLA_KV), scr, r, lane); continue; } r -= I_MKV;
            if (r < I_O) { transpose_item(a.mla_wo + (size_t)j * 1024 * 1024, nullptr, 1024, 1024, (bf16*)(wm + W_MLA_O), scr, r, lane); continue; } r -= I_O;
            if (r < I_DIN) { transpose_item(a.diff_w_in + (size_t)j * 1024 * 4096, nullptr, 1024, 4096, (bf16*)(wd + W_DIFF_IN), scr, r, lane); continue; } r -= I_DIN;
            transpose_item(a.diff_wo + (size_t)j * 1024 * 1024, nullptr, 1024, 1024, (bf16*)(wd + W_DIFF_O), scr, r, lane);
        }
    }
    {
        const int gt = bx * 512 + tid, ngt = G * 512;
        for (int i = gt; i < M * 16; i += ngt) {
            const int row = i >> 4, fi = i & 15;
            const float inv = (float)exp2(-(double)(2 * fi) / 32.0 * 13.287712379549449);
            const float ang = (float)a.pos[row] * inv;
            const double x = (double)ang; const double n = rint(x * 0.15915494309189535); const double rr = x - n * 6.283185307179586; const double r2 = rr * rr;
            double s = 1.0, c = 1.0;
#pragma unroll
            for (int k = 12; k >= 1; --k) { s = 1.0 - r2 / (double)((2 * k) * (2 * k + 1)) * s; c = 1.0 - r2 / (double)((2 * k - 1) * (2 * k)) * c; }
            RC[i] = (float)c; RS[i] = (float)(rr * s);
        }
        for (int i = gt; i < 4 * M; i += ngt) SSQ[i] = 0.f;
        for (int i = gt; i < 3456; i += ngt) ((unsigned*)(ws + WS_BAR))[i] = 0u;
        for (int i = gt; i < (int)AUX_ZERO_WORDS; i += ngt) ((unsigned*)(ws + WS_AUX + AUX_KN2))[i] = 0u;
        if (gt < 256) { const int* pp = a.pos + (gt >> 7) * SEQ + (gt & 127) * 64; int mn = pp[0], mx = pp[0];
            for (int k = 1; k < 64; ++k) { const int v = pp[k]; mn = min(mn, v); mx = max(mx, v); }
            ((int*)(ws + WS_AUX + AUX_TMIN))[gt] = mn; ((int*)(ws + WS_AUX + AUX_TMAX))[gt] = mx; }
        for (int i = gt; i < 2 * (MLA_IN_PAD - MLA_IN) * 1024 / 2; i += ngt) {
            const int j = i / ((MLA_IN_PAD - MLA_IN) * 512), w = i % ((MLA_IN_PAD - MLA_IN) * 512);
            ((unsigned*)(ws + WS_WMLA + (size_t)j * W_MLA_SZ + W_MLA_IN + (size_t)MLA_IN * 1024 * 2))[w] = 0u;
        }
        if (gt < 2) { const int j = gt; float s1 = 0.f, s2 = 0.f;
            for (int k = 0; k < 64; ++k) { s1 += a.lq1[j * 64 + k] * a.lk1[j * 64 + k]; s2 += a.lq2[j * 64 + k] * a.lk2[j * 64 + k]; }
            const float li = 0.8f - 0.6f * expf(-0.3f * (float)(2 * j + 1));
            PAR[j] = expf(s1) - expf(s2) + li; PAR[2 + j] = li; }
    }
    grid.sync();
    const XcdBarrier xbar = xcd_barrier_post((unsigned*)(a.ws + WS_BAR), bar_st);

#define PH_BEGIN const size_t oz_ = (size_t)(unsigned)opaque_u32(0u); unsigned char* ws = a.ws + oz_; \
    asm volatile("" : "+v"(tidv)); const int tid = tidv, lane = tid & 63, wave = __builtin_amdgcn_readfirstlane(tid >> 6); (void)lane; (void)wave; (void)ws; \
    const int bxp = opaque_u32(blockIdx.x), Gp = opaque_u32(gridDim.x); (void)bxp; (void)Gp;
    int tidv = threadIdx.x;
    for (int l = 0; l < DEPTH; ++l) {
        const int j = l >> 1;
        {
            PH_BEGIN
            const float* xin = (l == 0) ? (a.x + oz_) : (a.out + oz_); const float* modl = (const float*)(ws + WS_MOD) + l * 6144; bf16* HO = (bf16*)(ws + WS_HO);
            const float* ng = (a.norm_g + oz_) + l * D;
            for (int m = bxp * 8 + wave; m < M; m += Gp * 8) {
                const f32x4* xr = (const f32x4*)(xin + (size_t)m * D) + lane; f32x4 v[4]; float s = 0.f;
#pragma unroll
                for (int q = 0; q < 4; ++q) { v[q] = __builtin_nontemporal_load(xr + 64 * q); s += dot4(v[q]); }
                const float r = rsqrtf(wave_sum(s) * (1.0f / D) + EPS);
                const float* md = modl + (m >> 13) * 3072;
#pragma unroll
                for (int q = 0; q < 4; ++q) { const int col = 4 * lane + 256 * q;
                    const f32x4 gg = *(const f32x4*)(ng + col), sh = *(const f32x4*)(md + col), sc = *(const f32x4*)(md + 1024 + col);
                    st4(HO + (size_t)m * D + col, (v[q] * r) * gg * (sc + 1.0f) + sh); }
            }
        }
        xcd_barrier(xbar);
        if ((l & 1) == 0) {
            {   PH_BEGIN
                unsigned char* wm = ws + WS_WMLA + (size_t)j * W_MLA_SZ;
                run_gemm(ldsl, (const bf16*)(ws + WS_HO), 1024, (const bf16*)(wm + W_MLA_IN), MLA_IN_PAD, 1024, E1{ws, j}, tid, bxp, Gp);
            }
            xcd_barrier(xbar);
            {   PH_BEGIN
                unsigned char* wm = ws + WS_WMLA + (size_t)j * W_MLA_SZ;
                run_gemm(ldsl, (const bf16*)(ws + WS_QL), 384, (const bf16*)(wm + W_MLA_Q), 1536, 384, E2{ws, j}, tid, bxp, Gp);
            }
            {   PH_BEGIN
                unsigned char* wm = ws + WS_WMLA + (size_t)j * W_MLA_SZ;
                run_gemm(ldsl, (const bf16*)(ws + WS_KVL), 256, (const bf16*)(wm + W_MLA_KV), 2048, 256, E3{ws, j}, tid, bxp, Gp);
            }
            xcd_barrier(xbar);
            {
                PH_BEGIN
                bf16* HO = (bf16*)(ws + WS_HO); const bf16* Qb = (const bf16*)(ws + WS_Q); const bf16* KR = (const bf16*)(ws + WS_KR);
                const bf16* Kb = (const bf16*)(ws + WS_K); const bf16* Vb = (const bf16*)(ws + WS_V); const bf16* Gb = (const bf16*)(ws + WS_G);
                const int vcup = (Gp % 8 == 0) ? (bxp % 8) * (Gp / 8) + bxp / 8 : bxp;
                for (int u = vcup; u < NB * 16 * 16; u += Gp) {
                    const int bh = u >> 4, qb = u & 15, b = bh >> 4, h = bh & 15;
                    asm volatile("" : "+v"(tidv)); const int tid = tidv, lane = tid & 63;
                    const int r32 = lane & 31, hi = lane >> 5; const size_t row0 = (size_t)b * SEQ + qb * 512 + wave * 64;
                    const bf16* qrow0 = Qb + (row0 + r32) * 1536 + h * 96 + hi * 8; const bf16* qrow1 = qrow0 + 32 * 1536;
                    float qa = 0.f, qc = 0.f;
#pragma unroll
                    for (int d0 = 0; d0 < 6; ++d0) { const att::bf16x8 v = *reinterpret_cast<const att::bf16x8*>(qrow0 + d0 * 16), w = *reinterpret_cast<const att::bf16x8*>(qrow1 + d0 * 16);
#pragma unroll
                        for (int e = 0; e < 8; ++e) { const float f = bf2f((bf16)v[e]), g2 = bf2f((bf16)w[e]); qa = fmaf(f, f, qa); qc = fmaf(g2, g2, qc); } }
                    qa = add_xor32(qa); qc = add_xor32(qc);
                    const unsigned* knm = (const unsigned*)(ws + WS_AUX + AUX_KNM) + (j * 2 + b) * 32 + h * 2; const unsigned* krm = (const unsigned*)(ws + WS_AUX + AUX_KRM) + (j * 2 + b) * 16;
                    const float kmax2 = __uint_as_float(knm[0]) + __uint_as_float(knm[1]) + __uint_as_float(krm[0]);
                    const float bnd0 = 1.02f * sqrtf(qa * kmax2) + 0.01f, bnd1 = 1.02f * sqrtf(qc * kmax2) + 0.01f;
                    volatile int* bigf = (volatile int*)(lds + 98304);
                    __syncthreads(); if (tid == 0) bigf[0] = 0; __syncthreads(); if (fmaxf(bnd0, bnd1) > 60.0f) bigf[0] = 1; __syncthreads();
                    const bf16* Kh = Kb + (size_t)b * SEQ * 1024 + h * 64; const bf16* Vh = Vb + (size_t)b * SEQ * 1024 + h * 64; const bf16* Krb = KR + (size_t)b * SEQ * 32;
                    if (bigf[0] == 0) {
                        att::f32x16 o2[2][2];
                        const bf16* qr0 = qrow0; asm volatile("" : "+v"(qr0));
                        att::attn_mla2(qr0, qr0 + 32 * 1536, Kh, Krb, Vh, (char*)lds, o2, tid, -bnd0, -bnd1);
                        asm volatile("" : "+v"(tidv));
                        const int lane_e = tidv & 63, r32e = lane_e & 31, hie = lane_e >> 5; const size_t row0e = (size_t)b * SEQ + qb * 512 + (size_t)__builtin_amdgcn_readfirstlane(tidv >> 6) * 64;
                        float* stg = (float*)lds + (size_t)__builtin_amdgcn_readfirstlane(tidv >> 6) * (32 * 68);
#pragma unroll
                        for (int rb = 0; rb < 2; ++rb) {
#pragma unroll
                            for (int r = 0; r < 16; ++r)
#pragma unroll
                                for (int d = 0; d < 2; ++d) stg[att::crow(r, hie) * 68 + d * 32 + r32e] = o2[rb][d][r];
                            asm volatile("s_waitcnt lgkmcnt(0)" ::: "memory");
#pragma unroll
                            for (int i = 0; i < 4; ++i) { const int rw = i * 8 + (lane_e >> 3), cc = (lane_e & 7) * 8;
                                const f32x4 v0 = *(const f32x4*)(stg + rw * 68 + cc), v1 = *(const f32x4*)(stg + rw * 68 + cc + 4);
                                const size_t off = (row0e + rb * 32 + rw) * 1024 + h * 64 + cc;
                                const u32x4 g = *(const u32x4*)(Gb + off);
                                const f32x4 g0 = {__uint_as_float(g.x << 16), __uint_as_float(g.x & 0xffff0000u), __uint_as_float(g.y << 16), __uint_as_float(g.y & 0xffff0000u)};
                                const f32x4 g1 = {__uint_as_float(g.z << 16), __uint_as_float(g.z & 0xffff0000u), __uint_as_float(g.w << 16), __uint_as_float(g.w & 0xffff0000u)};
                                st8(HO + off, v0 * g0, v1 * g1); }
                            asm volatile("s_waitcnt lgkmcnt(0)" ::: "memory");
                        }
                    } else {
#pragma unroll 1
                        for (int half = 0; half < 2; ++half) {
                            const size_t rw0 = (size_t)b * SEQ + qb * 512 + half * 256 + wave * 32;
                            att::f32x16 o[2];
                            att::attn_pass<2, true, false, 2, false, false>(Qb + (rw0 + r32) * 1536 + h * 96 + hi * 8, Kh, 1024, Krb, Vh, 1024, nullptr, 0.f, 0.f, (char*)lds, o, tid, 0, SEQ / 64, 0.f);
#pragma unroll
                            for (int r = 0; r < 16; ++r) { const size_t row = rw0 + att::crow(r, hi);
#pragma unroll
                                for (int d = 0; d < 2; ++d) { const size_t off = row * 1024 + h * 64 + d * 32 + r32; HO[off] = (bf16)f2bf(o[d][r] * bf2f(Gb[off])); } }
                        }
                    }
                }
            }
            xcd_barrier(xbar);
            {   PH_BEGIN
                unsigned char* wm = ws + WS_WMLA + (size_t)j * W_MLA_SZ; const float* xin = (l == 0) ? (a.x + oz_) : (a.out + oz_);
                run_gemm(ldsl, (const bf16*)(ws + WS_HO), 1024, (const bf16*)(wm + W_MLA_O), 1024, 1024, E4{ws, xin, (a.out + oz_), l}, tid, bxp, Gp);
            }
            xcd_barrier(xbar);
        } else {
            {   PH_BEGIN
                unsigned char* wd = ws + WS_WDIFF + (size_t)j * W_DIFF_SZ;
                run_gemm(ldsl, (const bf16*)(ws + WS_HO), 1024, (const bf16*)(wd + W_DIFF_IN), 4096, 1024, E5{ws, j}, tid, bxp, Gp);
            }
            xcd_barrier(xbar);
            {
                PH_BEGIN
                bf16* HO = (bf16*)(ws + WS_HO); const bf16* Qb = (const bf16*)(ws + WS_Q);
                const bf16* Kb = (const bf16*)(ws + WS_K); const bf16* Vb = (const bf16*)(ws + WS_V); const bf16* Gb = (const bf16*)(ws + WS_G);
                const float* PAR = (const float*)(ws + WS_PAR); float* STASH = (float*)(ws + WS_STASH);
                const float lam = __uint_as_float(__builtin_amdgcn_readfirstlane(__float_as_uint(PAR[j]))), omli = 1.0f - __uint_as_float(__builtin_amdgcn_readfirstlane(__float_as_uint(PAR[2 + j])));
                unsigned* CNT = (unsigned*)(ws + WS_AUX + AUX_CNT) + j * 64;
                const int* TMIN = (const int*)(ws + WS_AUX + AUX_TMIN); const int* TMAX = (const int*)(ws + WS_AUX + AUX_TMAX);
                const unsigned* KN2 = (const unsigned*)(ws + WS_AUX + AUX_KN2) + (size_t)j * 256 * 32; const unsigned* QN2 = (const unsigned*)(ws + WS_AUX + AUX_QN2) + (size_t)j * 64 * 32;
                volatile int* sm = (volatile int*)(lds + 98304); volatile unsigned long long* smask = (volatile unsigned long long*)(lds + 98304 + 64);
                for (;;) {
                    __syncthreads();
                    if (tidv == 0) sm[0] = (int)atomicAdd(CNT, 1u);
                    __syncthreads();
                    const int qi = sm[0]; if (qi >= NB * 8 * 32) break;
                    const int h = 7 - (qi >> 6), b = (qi >> 5) & 1, qb = qi & 31;
                    asm volatile("" : "+v"(tidv)); const int tid = tidv, lane = tid & 63;
                    const int r32 = lane & 31, hi = lane >> 5; const size_t row0 = (size_t)b * SEQ + qb * 256 + wave * 32;
                    const float cpos = exp2f(-(float)(h + 1)) * LOG2E, cneg = -cpos;
                    const float pq = (float)(a.pos + oz_)[row0 + r32];
                    f32x4* st = (f32x4*)(STASH + ((size_t)bxp * 512 + tid) * 64);
                    att::f32x16 o[4];
#pragma unroll 1
                    for (int c = 0; c < 2; ++c) {
                        {
                            const bf16* qd = Qb + (row0 + r32) * 1024 + h * 128 + c * 64 + hi * 8; const bf16* kd = Kb + (row0 + r32) * 1024 + h * 128 + c * 64 + hi * 8;
                            float sii = 0.f;
#pragma unroll
                            for (int d0 = 0; d0 < 4; ++d0) { const att::bf16x8 qv = *reinterpret_cast<const att::bf16x8*>(qd + d0 * 16), kv = *reinterpret_cast<const att::bf16x8*>(kd + d0 * 16);
#pragma unroll
                                for (int e = 0; e < 8; ++e) sii = fmaf(bf2f((bf16)qv[e]), bf2f((bf16)kv[e]), sii); }
                            sii = add_xor32(sii);
                            sii = fminf(sii, swz_xor<1>(sii)); sii = fminf(sii, swz_xor<2>(sii)); sii = fminf(sii, swz_xor<4>(sii)); sii = fminf(sii, swz_xor<8>(sii)); sii = fminf(sii, swz_xor<16>(sii));
                            if (lane == 0) ((volatile float*)(lds + 98304 + 128))[wave] = sii;
                        }
                        __syncthreads();
                        if (tid < 128) {
                            const volatile float* smin = (const volatile float*)(lds + 98304 + 128);
                            const float mlb = fminf(fminf(fminf(smin[0], smin[1]), fminf(smin[2], smin[3])), fminf(fminf(smin[4], smin[5]), fminf(smin[6], smin[7]))) - 0.05f;
                            const int hm2 = (h * 2 + c) * 2, t = tid;
                            const unsigned* qp = QN2 + ((size_t)b * 32 + qb) * 32 + hm2; const float qn = sqrtf(__uint_as_float(qp[0]) + __uint_as_float(qp[1]));
                            const unsigned* kp = KN2 + ((size_t)b * 128 + t) * 32 + hm2; const float kn = sqrtf(__uint_as_float(kp[0]) + __uint_as_float(kp[1]));
                            int qmin = 0x7fffffff, qmax = -0x7fffffff;
#pragma unroll
                            for (int i = 0; i < 4; ++i) { qmin = min(qmin, TMIN[b * 128 + 4 * qb + i]); qmax = max(qmax, TMAX[b * 128 + 4 * qb + i]); }
                            const int dmin = max(0, max(qmin - TMAX[b * 128 + t], TMIN[b * 128 + t] - qmax));
                            const bool keep = 1.03f * qn * kn - cpos * (float)dmin > mlb - 32.0f;
                            const unsigned long long mk = __ballot(keep);
                            float kb = qn * kn;
                            kb = fmaxf(kb, swz_xor<1>(kb)); kb = fmaxf(kb, swz_xor<2>(kb)); kb = fmaxf(kb, swz_xor<4>(kb)); kb = fmaxf(kb, swz_xor<8>(kb)); kb = fmaxf(kb, swz_xor<16>(kb));
                            { auto rr = __builtin_amdgcn_permlane32_swap(__float_as_uint(kb), __float_as_uint(kb), false, false); kb = fmaxf(__uint_as_float(rr[0]), __uint_as_float(rr[1])); }
                            if (lane == 0) { smask[tid >> 6] = mk; ((volatile float*)(lds + 98304 + 192))[tid >> 6] = kb; }
                        }
                        __syncthreads();
                        const float bnd = 1.03f * fmaxf(((volatile float*)(lds + 98304 + 192))[0], ((volatile float*)(lds + 98304 + 192))[1]) + 0.01f;
                        const unsigned long long m0 = smask[0], m1 = smask[1];
                        int t_lo = m0 ? __builtin_ctzll(m0) : 64 + __builtin_ctzll(m1 | (1ull << 63));
                        int t_hi = m1 ? 127 - __builtin_clzll(m1) : 63 - __builtin_clzll(m0 | 1ull);
                        t_lo = min(t_lo, 4 * qb); t_hi = max(t_hi, 4 * qb + 3);
                        if (bnd > 60.0f && ((t_hi - t_lo + 1) & 1) != 0) { if (t_hi < 127) ++t_hi; else --t_lo; }
                        t_lo = __builtin_amdgcn_readfirstlane(t_lo); t_hi = __builtin_amdgcn_readfirstlane(t_hi);
                        asm volatile("" : "+v"(tidv));
                        if (bnd <= 60.0f)
                        att::attn_diff1(Qb + (row0 + r32) * 1024 + h * 128 + c * 64 + hi * 8, Kb + (size_t)b * SEQ * 1024 + h * 128 + c * 64, Vb + (size_t)b * SEQ * 1024 + h * 128,
                                        (a.pos + oz_) + (size_t)b * SEQ, pq, cneg, (char*)lds, o, tidv, t_lo, t_hi - t_lo + 1, -bnd);
                        else
                        att::attn_pass<4, false, true, 1, false, false>(Qb + (row0 + r32) * 1024 + h * 128 + c * 64 + hi * 8, Kb + (size_t)b * SEQ * 1024 + h * 128 + c * 64, 1024, nullptr,
                                                       Vb + (size_t)b * SEQ * 1024 + h * 128, 1024, (a.pos + oz_) + (size_t)b * SEQ, pq, cneg, (char*)lds, o, tidv, t_lo, t_hi - t_lo + 1, 0.f);
                        if (c == 0) {
#pragma unroll
                            for (int d = 0; d < 4; ++d)
#pragma unroll
                                for (int r = 0; r < 4; ++r) st[d * 4 + r] = (f32x4){o[d][4 * r], o[d][4 * r + 1], o[d][4 * r + 2], o[d][4 * r + 3]};
                        }
                    }
                    float ss[16];
#pragma unroll
                    for (int r = 0; r < 16; ++r) ss[r] = 0.f;
#pragma unroll
                    for (int d = 0; d < 4; ++d)
#pragma unroll
                        for (int r = 0; r < 4; ++r) { const f32x4 s0 = st[d * 4 + r];
#pragma unroll
                            for (int q = 0; q < 4; ++q) { const float v = s0[q] - lam * o[d][4 * r + q]; o[d][4 * r + q] = v; ss[4 * r + q] += v * v; } }
#pragma unroll
                    for (int r = 0; r < 16; ++r) { float v = ss[r]; v += swz_xor<1>(v); v += swz_xor<2>(v); v += swz_xor<4>(v); v += swz_xor<8>(v); v += swz_xor<16>(v); ss[r] = v; }
                    const float* hg = (a.head_g + oz_) + j * 128;
#pragma unroll
                    for (int r = 0; r < 16; ++r) ss[r] = rsqrtf(ss[r] * (1.0f / 128.0f) + EPS) * omli;
                    float* stg = (float*)lds + (size_t)wave * (32 * 68);
#pragma unroll
                    for (int half = 0; half < 2; ++half) {
#pragma unroll
                        for (int r = 0; r < 16; ++r)
#pragma unroll
                            for (int d2 = 0; d2 < 2; ++d2) stg[att::crow(r, hi) * 68 + d2 * 32 + r32] = o[half * 2 + d2][r] * ss[r];
                        asm volatile("s_waitcnt lgkmcnt(0)" ::: "memory");
#pragma unroll
                        for (int i = 0; i < 4; ++i) { const int rw = i * 8 + (lane >> 3), cc = (lane & 7) * 8, col = half * 64 + cc;
                            const f32x4 v0 = *(const f32x4*)(stg + rw * 68 + cc), v1 = *(const f32x4*)(stg + rw * 68 + cc + 4);
                            const size_t off = (row0 + rw) * 1024 + h * 128 + col;
                            const u32x4 g = *(const u32x4*)(Gb + off);
                            const f32x4 g0 = {__uint_as_float(g.x << 16), __uint_as_float(g.x & 0xffff0000u), __uint_as_float(g.y << 16), __uint_as_float(g.y & 0xffff0000u)};
                            const f32x4 g1 = {__uint_as_float(g.z << 16), __uint_as_float(g.z & 0xffff0000u), __uint_as_float(g.w << 16), __uint_as_float(g.w & 0xffff0000u)};
                            const f32x4 h0 = *(const f32x4*)(hg + col), h1 = *(const f32x4*)(hg + col + 4);
                            st8(HO + off, v0 * h0 * g0, v1 * h1 * g1); }
                        asm volatile("s_waitcnt lgkmcnt(0)" ::: "memory");
                    }
                }
            }
            xcd_barrier(xbar);
            {   PH_BEGIN
                unsigned char* wd = ws + WS_WDIFF + (size_t)j * W_DIFF_SZ; const float* xin = (a.out + oz_);
                run_gemm(ldsl, (const bf16*)(ws + WS_HO), 1024, (const bf16*)(wd + W_DIFF_O), 1024, 1024, E4{ws, xin, (a.out + oz_), l}, tid, bxp, Gp);
            }
            xcd_barrier(xbar);
        }
    }
    {
        PH_BEGIN
        for (int m = bxp * 8 + wave; m < M; m += Gp * 8) {
            f32x4* xr = (f32x4*)((a.out + oz_) + (size_t)m * D) + lane; f32x4 v[4]; float s = 0.f;
#pragma unroll
            for (int q = 0; q < 4; ++q) { v[q] = __builtin_nontemporal_load(xr + 64 * q); s += dot4(v[q]); }
            const float r = rsqrtf(wave_sum(s) * (1.0f / D) + EPS);
#pragma unroll
            for (int q = 0; q < 4; ++q) { const f32x4 gg = *(const f32x4*)((a.final_g + oz_) + 4 * lane + 256 * q); xr[64 * q] = (v[q] * r) * gg; }
        }
    }
}

extern "C" void kernel_launch(void* const* d_in, const int* in_sizes, int n_in, void* d_out, int out_size, void* d_ws, size_t ws_size, hipStream_t stream) {
    static int grid_blocks = 0;
    if (grid_blocks == 0) {
        if (n_in != 20 || in_sizes[0] != M * D || out_size != M * D || ws_size < WS_END) { fprintf(stderr, "kernel_launch: unexpected shapes (n_in %d, in0 %d, out %d, ws %zu)\n", n_in, n_in > 0 ? in_sizes[0] : -1, out_size, ws_size); grid_blocks = -1; return; }
        int dev = 0, cus = 0, per_cu = 0;
        hipGetDevice(&dev); hipDeviceGetAttribute(&cus, hipDeviceAttributeMultiprocessorCount, dev);
        if (hipFuncSetAttribute((const void*)fwd_kernel, hipFuncAttributeMaxDynamicSharedMemorySize, LDS_BYTES) != hipSuccess) { fprintf(stderr, "kernel_launch: hipFuncSetAttribute failed\n"); grid_blocks = -1; return; }
        hipOccupancyMaxActiveBlocksPerMultiprocessor(&per_cu, (const void*)fwd_kernel, 512, LDS_BYTES);
        if (per_cu < 1) per_cu = 1;
        grid_blocks = cus * per_cu;
        (void)hipGetLastError();
    }
    if (grid_blocks < 0) return;
    Args a{};
    a.x = (const float*)d_in[0]; a.c = (const float*)d_in[1]; a.pos = (const int*)d_in[2]; a.ada_w = (const float*)d_in[3]; a.ada_b = (const float*)d_in[4]; a.norm_g = (const float*)d_in[5];
    a.mla_w_in = (const float*)d_in[6]; a.mla_qg = (const float*)d_in[7]; a.mla_wq = (const float*)d_in[8]; a.mla_kvg = (const float*)d_in[9]; a.mla_wkv = (const float*)d_in[10]; a.mla_wo = (const float*)d_in[11];
    a.diff_w_in = (const float*)d_in[12]; a.lq1 = (const float*)d_in[13]; a.lk1 = (const float*)d_in[14]; a.lq2 = (const float*)d_in[15]; a.lk2 = (const float*)d_in[16]; a.head_g = (const float*)d_in[17];
    a.diff_wo = (const float*)d_in[18]; a.final_g = (const float*)d_in[19];
    a.out = (float*)d_out; a.ws = (unsigned char*)d_ws;
    void* args[] = {&a};
    hipError_t e = hipLaunchCooperativeKernel((const void*)fwd_kernel, dim3(grid_blocks), dim3(512), args, LDS_BYTES, stream);
    if (e != hipSuccess) fprintf(stderr, "cooperative launch failed: %s (grid %d)\n", hipGetErrorString(e), grid_blocks);
}
```

```cpp
#include <hip/hip_runtime.h>
#include <hip/hip_cooperative_groups.h>
#include <cstdio>
#include <cstdint>
namespace cg = cooperative_groups;
namespace pg8 {
#define PG8_LAS __attribute__((address_space(3)))
typedef unsigned short bf16_t;
typedef short bf16x8 __attribute__((ext_vector_type(8)));
typedef float f32x4 __attribute__((ext_vector_type(4)));
typedef unsigned u32x4 __attribute__((ext_vector_type(4)));
constexpr int BM = 256, BK = 64, HALF = 128, HTB = HALF * BK * 2  , STAGE_BYTES = 8 * HTB, NXCD = 8, WGM = 8;

__host__ __device__ __forceinline__ int lds_byte(int r, int c) { const int st = (r >> 4) * 2 + (c >> 5), rr = r & 15, cc = c & 31, ob = rr * 64 + cc * 2; return st * 1024 + (ob ^ (((ob >> 9) & 1) << 5)); }
__host__ __device__ __forceinline__ void stage_rc(int b, int& R, int& C) { const int st = b / 1024, sb = b % 1024, swz = sb ^ (((sb >> 9) & 1) << 5); R = (st >> 1) * 16 + swz / 64; C = (st & 1) * 32 + (swz % 64) / 2; }
__host__ __device__ __forceinline__ int perm32(int rho) { const int n = rho >> 4, i = rho & 15; return 8 * (i >> 2) + 4 * n + (i & 3); }

struct Unit { int pm, pn; };
struct Gemm { const bf16_t* A; const bf16_t* Bt; int M, N, K, lda; };

struct StaticOrder {
    int nM, nN, nwg, G, c;
    __host__ __device__ void init(int M, int N, int G_, int c_) { nM = M / BM; nN = N / BM; nwg = nM * nN; G = G_; c = c_; }
    __host__ __device__ bool next(int i, Unit& u) const {
        const long L = (long)i * G + c; if (L >= nwg) return false;
        int wgid = (int)L; { const int q = nwg / NXCD, r = nwg % NXCD, xcd = wgid % NXCD, off = wgid / NXCD; wgid = (xcd < r ? xcd * (q + 1) : r * (q + 1) + (xcd - r) * q) + off; }
        const int nig = WGM * nN, gid = wgid / nig, fm = gid * WGM, gsz = (nM - fm) < WGM ? (nM - fm) : WGM;
        u.pm = fm + ((wgid % nig) % gsz); u.pn = (wgid % nig) / gsz; return true;
    }
    __device__ __forceinline__ void a_ready(const Unit&) const {}
    __device__ __forceinline__ void done(const Unit&) const {}
};
template <class F> struct EpiF {
    static constexpr bool PERM = F::PERM, AFTER_DRAIN = false;
    F f;
    __device__ __forceinline__ void operator()(const f32x4 (&acc)[2][2][4][2], const Unit& u, int wr, int wc, int fr, int fq) const {
        F g = f; g.launder();
#pragma unroll
        for (int ai = 0; ai < 2; ++ai)
#pragma unroll
            for (int m = 0; m < 4; ++m) { const int row = u.pm * BM + ai * HALF + wr * 64 + m * 16 + fr;
#pragma unroll
                for (int bj = 0; bj < 2; ++bj) { const int col = u.pn * BM + bj * HALF + wc * 32 + (PERM ? 8 : 4) * fq; g(row, col, acc[ai][bj][m][0], acc[ai][bj][m][1]); }
                asm volatile("" ::: "memory"); }
    }
};
template <class Epi, class Sched, bool ALIGN_EPI = false, bool SP2 = false>
__device__ __forceinline__ void gemm_phase(PG8_LAS unsigned char* lds, const Gemm g, const Sched& S, const Epi& E, const int tid) {
    const int wid = __builtin_amdgcn_readfirstlane(tid >> 6), lane = tid & 63, wr = wid >> 2, wc = wid & 3, fr = lane & 15, fq = lane >> 4;
    const int K = g.K, nt = K / BK;
    unsigned voffA[2], voffB[2];
#pragma unroll
    for (int i = 0; i < 2; ++i) { int R, C; stage_rc(tid * 16 + i * 8192, R, C); const int Rb = Epi::PERM ? ((R & ~31) + perm32(R & 31)) : R;
        voffA[i] = (unsigned)(R * g.lda + C) * 2u; voffB[i] = (unsigned)(Rb * K + C) * 2u; }
    const size_t kstep = (size_t)(BK * 2);
    const size_t hstep = (size_t)HALF * K * 2, hstepA = (size_t)HALF * g.lda * 2;
    const size_t tstep = 2 * hstep, tstepA = 2 * hstepA;
    const unsigned ldsw = (unsigned)wid * 1024u;
    const int aoff = lds_byte(wr * 64 + fr, fq * 8), boff = lds_byte(wc * 32 + fr, fq * 8);
#define PG8_SA(b, h) (((b) * 2 + (h)) * HTB)
#define PG8_SB(b, h) ((4 + (b) * 2 + (h)) * HTB)
#define PG8_STAGE(bufoff, gbase, voff) do { _Pragma("unroll") for (int _i = 0; _i < 2; ++_i) \
        __builtin_amdgcn_global_load_lds((const unsigned*)((const char*)(gbase) + (voff)[_i]), (PG8_LAS unsigned*)(lds + (bufoff) + ldsw + _i * 8192), 16, 0, 0); } while (0)
#define PG8_LDA(dst, b, h) do { _Pragma("unroll") for (int m = 0; m < 4; ++m) _Pragma("unroll") for (int k = 0; k < 2; ++k) dst[m][k] = *(const PG8_LAS bf16x8*)(lds + PG8_SA(b, h) + aoff + m * 2048 + k * 1024); } while (0)
#define PG8_LDB(dst, b, h) do { _Pragma("unroll") for (int n = 0; n < 2; ++n) _Pragma("unroll") for (int k = 0; k < 2; ++k) dst[n][k] = *(const PG8_LAS bf16x8*)(lds + PG8_SB(b, h) + boff + n * 2048 + k * 1024); } while (0)
#define PG8_MMA(ai, bj, At, Bt) do { __builtin_amdgcn_s_setprio(1); _Pragma("unroll") for (int m = 0; m < 4; ++m) _Pragma("unroll") for (int n = 0; n < 2; ++n) _Pragma("unroll") for (int k = 0; k < 2; ++k) \
        acc[ai][bj][m][n] = __builtin_amdgcn_mfma_f32_16x16x32_bf16(Bt[n][k], At[m][k], acc[ai][bj][m][n], 0, 0, 0); __builtin_amdgcn_s_setprio(0); } while (0)
#define PG8_WAIT_V(n) asm volatile("s_waitcnt vmcnt(" #n ")" ::: "memory")
#define PG8_WAIT_L(n) asm volatile("s_waitcnt lgkmcnt(" #n ")" ::: "memory")
#define PG8_BAR __builtin_amdgcn_s_barrier()
#define PG8_SCHED __builtin_amdgcn_sched_barrier(0)
    Unit cur, nxt; int ui = 0;
    if (!S.next(0, cur)) return;
    f32x4 acc[2][2][4][2];
#pragma unroll
    for (int a = 0; a < 2; ++a)
#pragma unroll
        for (int b = 0; b < 2; ++b)
#pragma unroll
            for (int m = 0; m < 4; ++m)
#pragma unroll
                for (int n = 0; n < 2; ++n) acc[a][b][m][n] = (f32x4){0.f, 0.f, 0.f, 0.f};
    bf16x8 At[4][2], B0[2][2], B1[2][2];
    const char* cA = (const char*)g.A + (size_t)cur.pm * tstepA; const char* cB = (const char*)g.Bt + (size_t)cur.pn * tstep;
    S.a_ready(cur);
    if constexpr (SP2) {
        PG8_STAGE(PG8_SB(0, 0), cB, voffB); PG8_STAGE(PG8_SB(0, 1), cB + hstep, voffB); PG8_STAGE(PG8_SA(0, 0), cA, voffA); PG8_STAGE(PG8_SA(0, 1), cA + hstepA, voffA);
        if (wr == 1) PG8_BAR;
        PG8_WAIT_V(2); PG8_BAR;
        PG8_STAGE(PG8_SB(1, 0), cB + kstep, voffB); PG8_STAGE(PG8_SA(1, 0), cA + kstep, voffA); PG8_STAGE(PG8_SB(1, 1), cB + hstep + kstep, voffB);
        PG8_WAIT_V(6); PG8_BAR;
    } else {
        PG8_STAGE(PG8_SB(0, 0), cB, voffB); PG8_STAGE(PG8_SA(0, 0), cA, voffA); PG8_STAGE(PG8_SB(0, 1), cB + hstep, voffB); PG8_STAGE(PG8_SA(0, 1), cA + hstepA, voffA);
        if (wr == 1) PG8_BAR;
        PG8_WAIT_V(4); PG8_BAR;
        PG8_STAGE(PG8_SB(1, 0), cB + kstep, voffB); PG8_STAGE(PG8_SA(1, 0), cA + kstep, voffA); PG8_STAGE(PG8_SB(1, 1), cB + hstep + kstep, voffB);
        PG8_WAIT_V(6); PG8_BAR;
    }
    for (;;) {
        const bool has_next = S.next(ui + 1, nxt);
        const char* nA = has_next ? (const char*)g.A + (size_t)nxt.pm * tstepA : cA; const char* nB = has_next ? (const char*)g.Bt + (size_t)nxt.pn * tstep : cB;
        for (int t = 0; t < nt; t += 2) {
            const bool last = (t == nt - 2);
            const char* a1 = cA + (size_t)(t + 1) * kstep;
            const char* a2 = last ? nA : cA + (size_t)(t + 2) * kstep; const char* b2 = last ? nB : cB + (size_t)(t + 2) * kstep;
            const char* a3 = a2 + kstep; const char* b3 = b2 + kstep;
            if (last && has_next) S.a_ready(nxt);
            if constexpr (SP2) {
            PG8_LDB(B0, 0, 0); PG8_LDB(B1, 0, 1); PG8_SCHED; PG8_LDA(At, 0, 0); PG8_STAGE(PG8_SA(1, 1), a1 + hstepA, voffA);
            PG8_WAIT_V(8); PG8_WAIT_L(0); PG8_BAR; PG8_MMA(0, 0, At, B0); PG8_MMA(0, 1, At, B1); PG8_BAR; PG8_SCHED;
            PG8_LDA(At, 0, 1); PG8_STAGE(PG8_SB(0, 0), b2, voffB); PG8_STAGE(PG8_SB(0, 1), b2 + hstep, voffB); PG8_STAGE(PG8_SA(0, 0), a2, voffA);
            PG8_WAIT_V(8); PG8_WAIT_L(0); PG8_BAR; PG8_MMA(1, 0, At, B0); PG8_MMA(1, 1, At, B1); PG8_BAR; PG8_SCHED;
            PG8_LDB(B0, 1, 0); PG8_LDB(B1, 1, 1); PG8_SCHED; PG8_LDA(At, 1, 0); PG8_STAGE(PG8_SA(0, 1), a2 + hstepA, voffA);
            PG8_WAIT_V(8); PG8_WAIT_L(0); PG8_BAR; PG8_MMA(0, 0, At, B0); PG8_MMA(0, 1, At, B1); PG8_BAR; PG8_SCHED;
            PG8_LDA(At, 1, 1); PG8_STAGE(PG8_SB(1, 0), b3, voffB); PG8_STAGE(PG8_SB(1, 1), b3 + hstep, voffB); PG8_STAGE(PG8_SA(1, 0), a3, voffA);
            PG8_WAIT_V(8); PG8_WAIT_L(0); PG8_BAR; PG8_MMA(1, 0, At, B0); PG8_MMA(1, 1, At, B1); PG8_BAR; PG8_SCHED;
            } else {
            PG8_LDB(B0, 0, 0); PG8_SCHED; PG8_LDA(At, 0, 0); PG8_STAGE(PG8_SA(1, 1), a1 + hstepA, voffA);
            PG8_WAIT_L(8); PG8_BAR; PG8_WAIT_L(0); PG8_MMA(0, 0, At, B0); PG8_BAR; PG8_SCHED;
            PG8_LDB(B1, 0, 1); PG8_STAGE(PG8_SB(0, 0), b2, voffB);
            PG8_BAR; PG8_WAIT_L(0); PG8_MMA(0, 1, At, B1); PG8_BAR;
            PG8_LDA(At, 0, 1); PG8_STAGE(PG8_SA(0, 0), a2, voffA);
            PG8_BAR; PG8_WAIT_L(0); PG8_MMA(1, 0, At, B0); PG8_BAR; PG8_SCHED;
            PG8_STAGE(PG8_SB(0, 1), b2 + hstep, voffB);
            PG8_WAIT_V(6); PG8_BAR; PG8_MMA(1, 1, At, B1); PG8_BAR;
            PG8_LDB(B0, 1, 0); PG8_SCHED; PG8_LDA(At, 1, 0); PG8_STAGE(PG8_SA(0, 1), a2 + hstepA, voffA);
            PG8_WAIT_L(8); PG8_BAR; PG8_WAIT_L(0); PG8_MMA(0, 0, At, B0); PG8_BAR; PG8_SCHED;
            PG8_LDB(B1, 1, 1); PG8_STAGE(PG8_SB(1, 0), b3, voffB);
            PG8_BAR; PG8_WAIT_L(0); PG8_MMA(0, 1, At, B1); PG8_BAR;
            PG8_LDA(At, 1, 1); PG8_STAGE(PG8_SA(1, 0), a3, voffA);
            PG8_BAR; PG8_WAIT_L(0); PG8_MMA(1, 0, At, B0); PG8_BAR; PG8_SCHED;
            PG8_STAGE(PG8_SB(1, 1), b3 + hstep, voffB);
            PG8_WAIT_V(6); PG8_BAR; PG8_MMA(1, 1, At, B1); PG8_BAR;
            }
        }
        if constexpr (ALIGN_EPI) { if (wr == 0) PG8_BAR; }
        if constexpr (!Epi::AFTER_DRAIN) { E(acc, cur, wr, wc, fr, fq); S.done(cur); }
        if (!has_next) break;
#pragma unroll
        for (int a = 0; a < 2; ++a)
#pragma unroll
            for (int b = 0; b < 2; ++b)
#pragma unroll
                for (int m = 0; m < 4; ++m)
#pragma unroll
                    for (int n = 0; n < 2; ++n) acc[a][b][m][n] = (f32x4){0.f, 0.f, 0.f, 0.f};
        cur = nxt; cA = nA; cB = nB; ++ui;
        if constexpr (ALIGN_EPI) { if (wr == 1) PG8_BAR; }
    }
    PG8_WAIT_V(0);
    if constexpr (!ALIGN_EPI) { if (wr == 0) PG8_BAR; }
    PG8_BAR;
    if constexpr (Epi::AFTER_DRAIN) { E.fused(acc, cur, wr, wc, fr, fq, lds, wid, lane); S.done(cur); }
#undef PG8_SA
#undef PG8_SB
#undef PG8_STAGE
#undef PG8_LDA
#undef PG8_LDB
#undef PG8_MMA
#undef PG8_WAIT_V
#undef PG8_WAIT_L
#undef PG8_BAR
#undef PG8_SCHED
}
}

constexpr int SEQ = 8192, NB = 2, M = NB * SEQ, D = 1024, DEPTH = 4;
constexpr float EPS = 1e-6f;
constexpr float LOG2E = 1.4426950408889634f;
constexpr float QSCALE_MLA = 0.10206207261596577f * LOG2E;
constexpr float QSCALE_DIFF = 0.125f * LOG2E;
constexpr int MLA_IN = 1696, MLA_IN_PAD = 1792;

typedef unsigned short bf16;
typedef float f32x4 __attribute__((ext_vector_type(4)));
typedef unsigned u32x2 __attribute__((ext_vector_type(2)));
typedef unsigned u32x4 __attribute__((ext_vector_type(4)));
#define LAS __attribute__((address_space(3)))

constexpr size_t MiB = 1u << 20;
constexpr size_t WS_MOD = 0;
constexpr size_t WS_PAR = 128 * 1024;
constexpr size_t WS_SSQ = 256 * 1024;
constexpr size_t WS_AUX = 512 * 1024;
constexpr size_t AUX_TMIN = 0, AUX_TMAX = 1024;
constexpr size_t AUX_KN2 = 4096;
constexpr size_t AUX_QN2 = AUX_KN2 + 65536;
constexpr size_t AUX_CNT = AUX_QN2 + 16384;
constexpr size_t AUX_KNM = AUX_CNT + 512;
constexpr size_t AUX_KRM = AUX_KNM + 512;
constexpr size_t AUX_ZERO_WORDS = (65536 + 16384 + 512 + 512 + 512) / 4;
constexpr size_t WS_BAR = 768 * 1024;
constexpr size_t WS_COS = 1 * MiB, WS_SIN = 2 * MiB;
constexpr size_t WS_W = 4 * MiB;
constexpr size_t W_MLA_IN = 0, W_MLA_Q = W_MLA_IN + (size_t)MLA_IN_PAD * 1024 * 2, W_MLA_KV = W_MLA_Q + (size_t)1536 * 384 * 2,
                 W_MLA_O = W_MLA_KV + (size_t)2048 * 256 * 2, W_MLA_SZ = W_MLA_O + (size_t)1024 * 1024 * 2;
constexpr size_t W_DIFF_IN = 0, W_DIFF_O = (size_t)4096 * 1024 * 2, W_DIFF_SZ = W_DIFF_O + (size_t)1024 * 1024 * 2;
constexpr size_t WS_WMLA = WS_W, WS_WDIFF = WS_W + 2 * W_MLA_SZ;
static_assert(WS_WDIFF + 2 * W_DIFF_SZ <= 40 * MiB, "weights fit");
constexpr size_t WS_HO = 40 * MiB;
constexpr size_t WS_Q = 72 * MiB;
constexpr size_t WS_STASH = 104 * MiB;
constexpr size_t WS_QL = 120 * MiB;
constexpr size_t WS_KVL = 132 * MiB;
constexpr size_t WS_KR = 140 * MiB;
constexpr size_t WS_K = 142 * MiB;
constexpr size_t WS_V = 174 * MiB;
constexpr size_t WS_G = 206 * MiB;
constexpr size_t WS_END = 238 * MiB;

constexpr int LDS_BYTES = 135168;

__device__ __forceinline__ unsigned cvtpk(float lo, float hi) { unsigned r; asm volatile("v_cvt_pk_bf16_f32 %0, %1, %2" : "=v"(r) : "v"(lo), "v"(hi)); return r; }
__device__ __forceinline__ void st4(bf16* p, f32x4 v) { u32x2 w; w.x = cvtpk(v[0], v[1]); w.y = cvtpk(v[2], v[3]); *(u32x2*)p = w; }
__device__ __forceinline__ float bf2f(bf16 b) { return __uint_as_float((unsigned)b << 16); }
__device__ __forceinline__ float silu1(float v) { return v * __builtin_amdgcn_rcpf(1.0f + __expf(-v)); }
__device__ __forceinline__ f32x4 silu4(f32x4 v) { return (f32x4){silu1(v[0]), silu1(v[1]), silu1(v[2]), silu1(v[3])}; }
__device__ __forceinline__ float dot4(f32x4 a) { return (a[0] * a[0] + a[1] * a[1]) + (a[2] * a[2] + a[3] * a[3]); }
template <int X> __device__ __forceinline__ float swz_xor(float v) { return __int_as_float(__builtin_amdgcn_ds_swizzle(__float_as_int(v), (X << 10) | 0x1f)); }
__device__ __forceinline__ float add_xor32(float v) { auto rr = __builtin_amdgcn_permlane32_swap(__float_as_uint(v), __float_as_uint(v), false, false); return __uint_as_float(rr[0]) + __uint_as_float(rr[1]); }
__device__ __forceinline__ float wave_sum(float v) {
    v += swz_xor<1>(v); v += swz_xor<2>(v); v += swz_xor<4>(v); v += swz_xor<8>(v); v += swz_xor<16>(v); return add_xor32(v);
}

__device__ __forceinline__ void st8(bf16* p, f32x4 a, f32x4 b) { u32x4 w; w.x = cvtpk(a[0], a[1]); w.y = cvtpk(a[2], a[3]); w.z = cvtpk(b[0], b[1]); w.w = cvtpk(b[2], b[3]); *(u32x4*)p = w; }
__device__ __forceinline__ void rope8(f32x4& a, f32x4& b, const float* rc_row, const float* rs_row, int ci) {
    const bool upper = ci >= 16; const int i = ci & 15;
    f32x4 pa, pb;
#pragma unroll
    for (int e = 0; e < 4; ++e) {
        auto ra = __builtin_amdgcn_permlane32_swap(__float_as_uint(a[e]), __float_as_uint(a[e]), false, false); pa[e] = __uint_as_float(upper ? ra[0] : ra[1]);
        auto rb = __builtin_amdgcn_permlane32_swap(__float_as_uint(b[e]), __float_as_uint(b[e]), false, false); pb[e] = __uint_as_float(upper ? rb[0] : rb[1]);
    }
    const f32x4 c0 = *(const f32x4*)(rc_row + i), c1 = *(const f32x4*)(rc_row + i + 4), s0 = *(const f32x4*)(rs_row + i), s1 = *(const f32x4*)(rs_row + i + 4);
    if (!upper) { a = a * c0 - pa * s0; b = b * c1 - pb * s1; }
    else { a = pa * s0 + a * c0; b = pb * s1 + b * c1; }
}
template <class T> __device__ __forceinline__ T* opaque_uniform(T* p) { asm volatile("" : "+s"(p)); return p; }
__device__ __forceinline__ int opaque_u32(unsigned v) { asm volatile("" : "+s"(v)); return (int)v; }
__device__ __forceinline__ void atomic_max_f32_filtered(unsigned* p, float v) { if (v > __uint_as_float(*(volatile unsigned*)p)) atomicMax(p, __float_as_uint(v)); }
#define LAUNDER_WS __device__ __forceinline__ void launder() { ws += (size_t)(unsigned)opaque_u32(0u); }
struct E1 {
    static constexpr bool PERM = true;
    unsigned char* ws; int j; LAUNDER_WS
    __device__ __forceinline__ void operator()(int row, int col, f32x4 a, f32x4 b) const {
        bf16 *QL = (bf16*)(ws + WS_QL), *KVL = (bf16*)(ws + WS_KVL), *KR = (bf16*)(ws + WS_KR), *G = (bf16*)(ws + WS_G);
        float *ssq_q = (float*)(ws + WS_SSQ) + (size_t)j * 2 * M, *ssq_kv = ssq_q + M; const float *rc = (const float*)(ws + WS_COS), *rs = (const float*)(ws + WS_SIN);
        const int cb = col & ~31, ci = col & 31;
        if (cb < 384) {
            st8(QL + (size_t)row * 384 + col, a, b);
            float s = dot4(a) + dot4(b); s += swz_xor<16>(s); s = add_xor32(s);
            if (ci == 0) atomicAdd(ssq_q + row, s);
        } else if (cb < 640) {
            st8(KVL + (size_t)row * 256 + (col - 384), a, b);
            float s = dot4(a) + dot4(b); s += swz_xor<16>(s); s = add_xor32(s);
            if (ci == 0) atomicAdd(ssq_kv + row, s);
        } else if (cb < 672) {
            rope8(a, b, rc + (size_t)row * 16, rs + (size_t)row * 16, ci);
            st8(KR + (size_t)row * 32 + ci, a, b);
            float n2 = dot4(a) + dot4(b); n2 += swz_xor<16>(n2); n2 = add_xor32(n2);
            n2 = fmaxf(n2, swz_xor<1>(n2)); n2 = fmaxf(n2, swz_xor<2>(n2)); n2 = fmaxf(n2, swz_xor<4>(n2)); n2 = fmaxf(n2, swz_xor<8>(n2));
            if ((ci | (row & 15)) == 0) atomic_max_f32_filtered((unsigned*)(ws + WS_AUX + AUX_KRM) + (j * 2 + (row >> 13)) * 16, n2);
        } else if (cb < MLA_IN) {
            st8(G + (size_t)row * 1024 + (col - 672), silu4(a), silu4(b));
        }
    }
};
struct E2 {
    static constexpr bool PERM = true;
    unsigned char* ws; int j; LAUNDER_WS
    __device__ __forceinline__ void operator()(int row, int col, f32x4 a, f32x4 b) const {
        bf16* Q = (bf16*)(ws + WS_Q); const float* ssq_q = (const float*)(ws + WS_SSQ) + (size_t)j * 2 * M; const float *rc = (const float*)(ws + WS_COS), *rs = (const float*)(ws + WS_SIN);
        const float r = rsqrtf(ssq_q[row] * (1.0f / 384.0f) + EPS) * QSCALE_MLA; a = a * r; b = b * r;
        const int cb = col >> 5, ci = col & 31;
        if ((cb % 3) == 2) rope8(a, b, rc + (size_t)row * 16, rs + (size_t)row * 16, ci);
        st8(Q + (size_t)row * 1536 + col, a, b);
    }
};
struct E3 {
    static constexpr bool PERM = true;
    unsigned char* ws; int j; LAUNDER_WS
    __device__ __forceinline__ void operator()(int row, int col, f32x4 a, f32x4 b) const {
        bf16 *K = (bf16*)(ws + WS_K), *V = (bf16*)(ws + WS_V); const float* ssq_kv = (const float*)(ws + WS_SSQ) + (size_t)j * 2 * M + M;
        const float r = rsqrtf(ssq_kv[row] * (1.0f / 256.0f) + EPS); a = a * r; b = b * r;
        const int head = col >> 7, w = col & 127;
        const size_t off = (size_t)row * 1024 + head * 64 + (w & 63);
        if (w < 64) { st8(K + off, a, b);
            float n2 = dot4(a) + dot4(b); n2 += swz_xor<16>(n2); n2 = add_xor32(n2);
            n2 = fmaxf(n2, swz_xor<1>(n2)); n2 = fmaxf(n2, swz_xor<2>(n2)); n2 = fmaxf(n2, swz_xor<4>(n2)); n2 = fmaxf(n2, swz_xor<8>(n2));
            if (((col & 31) | (row & 15)) == 0) atomic_max_f32_filtered((unsigned*)(ws + WS_AUX + AUX_KNM) + (j * 2 + (row >> 13)) * 32 + head * 2 + ((col >> 5) & 1), n2);
        } else st8(V + off, a, b);
    }
};
struct E4 {
    static constexpr bool PERM = false;
    unsigned char* ws; const float* xin; float* xout; int l; LAUNDER_WS
    __device__ __forceinline__ void operator()(int row, int col, f32x4 a, f32x4 b) const {
        const float* gp = (const float*)(ws + WS_MOD) + l * 6144 + 2048 + (row >> 13) * 3072 + col; const size_t off = (size_t)row * 1024 + col;
        const f32x4 g0 = *(const f32x4*)gp, g1 = *(const f32x4*)(gp + 16);
        const f32x4 x0 = *(const f32x4*)(xin + off), x1 = *(const f32x4*)(xin + off + 16);
        *(f32x4*)(xout + off) = x0 + g0 * a; *(f32x4*)(xout + off + 16) = x1 + g1 * b;
    }
};
struct E5 {
    static constexpr bool PERM = true;
    unsigned char* ws; int j; LAUNDER_WS
    __device__ __forceinline__ void operator()(int row, int col, f32x4 a, f32x4 b) const {
        bf16 *Qd = (bf16*)(ws + WS_Q), *Kd = (bf16*)(ws + WS_K), *Vd = (bf16*)(ws + WS_V), *G = (bf16*)(ws + WS_G);
        const int reg = col >> 10, c2 = col & 1023; const size_t off = (size_t)row * 1024 + c2;
        if (reg <= 1) {
            if (reg == 0) { a = a * QSCALE_DIFF; b = b * QSCALE_DIFF; st8(Qd + off, a, b); }
            else st8(Kd + off, a, b);
            float s = dot4(a) + dot4(b); s += swz_xor<16>(s); s = add_xor32(s);
            s = fmaxf(s, swz_xor<1>(s)); s = fmaxf(s, swz_xor<2>(s)); s = fmaxf(s, swz_xor<4>(s)); s = fmaxf(s, swz_xor<8>(s));
            if (((col & 31) | (row & 15)) == 0) {
                unsigned* p = (reg == 0) ? (unsigned*)(ws + WS_AUX + AUX_QN2) + ((size_t)j * 64 + (row >> 8)) * 32 + (c2 >> 5)
                                         : (unsigned*)(ws + WS_AUX + AUX_KN2) + ((size_t)j * 256 + (row >> 6)) * 32 + (c2 >> 5);
                atomic_max_f32_filtered(p, s);
            }
        }
        else if (reg == 2) st8(Vd + off, a, b);
        else st8(G + off, silu4(a), silu4(b));
    }
};

namespace att {
using bf16x8 = __attribute__((ext_vector_type(8))) short;
using s16x4 = __attribute__((ext_vector_type(4))) short;
using f32x16 = __attribute__((ext_vector_type(16))) float;
constexpr int KN_OFF = 0, KR_OFF = 9216, V_OFF = 14336, PK_OFF = 30720, BUF = 30976, WSF_OFF = 3 * BUF, ATT_LDS = WSF_OFF + 2048;
constexpr float THR = 8.0f;
#define SBAR() __builtin_amdgcn_sched_barrier(0)
__device__ __forceinline__ int crow(int r, int hi) { return (r & 3) + 8 * (r >> 2) + 4 * hi; }
template <int DVB> __device__ __forceinline__ int v_st(int k, int c) { const int kk = (k & ~0xC) | ((k & 4) << 1) | ((k & 8) >> 1); return ((kk >> 3) * DVB + (c >> 5)) * 512 + ((kk & 7) * 32 + (c & 31)) * 2; }
__device__ __forceinline__ int v_rd_base(int lane) { return ((lane & 3) << 3) | (((lane >> 2) & 3) << 6) | (((lane >> 4) & 1) << 5) | (((lane >> 5) & 1) << 8); }
template <int OFF> __device__ __forceinline__ s16x4 tr_read(int vb) { s16x4 r; asm volatile("ds_read_b64_tr_b16 %0, %1 offset:%2" : "=&v"(r) : "v"(vb), "i"(OFF) : "memory"); return r; }

template <bool BIAS>
__device__ __forceinline__ void partialSM(f32x16& p0, f32x16& p1, float& m_reg, float& alpha, const char* pkl, int hi, float pq, float cneg) {
    if constexpr (BIAS) {
#pragma unroll
        for (int i = 0; i < 4; ++i) {
            const f32x4 k0 = *(const f32x4*)(pkl + (8 * i + 4 * hi) * 4), k1 = *(const f32x4*)(pkl + (32 + 8 * i + 4 * hi) * 4);
#pragma unroll
            for (int j = 0; j < 4; ++j) { p0[4 * i + j] = fmaf(fabsf(pq - k0[j]), cneg, p0[4 * i + j]); p1[4 * i + j] = fmaf(fabsf(pq - k1[j]), cneg, p1[4 * i + j]); }
        }
    }
    float pmax = p0[0];
#pragma unroll
    for (int r = 1; r < 16; ++r) pmax = fmaxf(pmax, p0[r]);
#pragma unroll
    for (int r = 0; r < 16; ++r) pmax = fmaxf(pmax, p1[r]);
    { auto rr = __builtin_amdgcn_permlane32_swap(__float_as_uint(pmax), __float_as_uint(pmax), false, false); pmax = fmaxf(__uint_as_float(rr[0]), __uint_as_float(rr[1])); }
    float mn;
    if (__builtin_expect(__all(pmax - m_reg <= THR), 1)) { mn = m_reg; alpha = 1.f; }
    else { mn = fmaxf(m_reg, pmax); alpha = __builtin_amdgcn_exp2f(m_reg - mn); m_reg = mn; }
#pragma unroll
    for (int r = 0; r < 16; ++r) p0[r] = __builtin_amdgcn_exp2f(p0[r] - mn);
#pragma unroll
    for (int r = 0; r < 16; ++r) p1[r] = p1[r] - mn;
}
__device__ __forceinline__ void finishSM(f32x16& p0, f32x16& p1, float alpha, float& l_reg, bf16x8& pa0, bf16x8& pa1, bf16x8& pa2, bf16x8& pa3) {
#pragma unroll
    for (int r = 0; r < 16; ++r) p1[r] = __builtin_amdgcn_exp2f(p1[r]);
    float ps = 0;
#pragma unroll
    for (int r = 0; r < 16; ++r) ps += p0[r];
#pragma unroll
    for (int r = 0; r < 16; ++r) ps += p1[r];
    { auto rr = __builtin_amdgcn_permlane32_swap(__float_as_uint(ps), __float_as_uint(ps), false, false); ps = __uint_as_float(rr[0]) + __uint_as_float(rr[1]); }
    l_reg = l_reg * alpha + ps;
#define PK4(P, BASE, OUT) do { unsigned a0 = cvtpk(P[BASE + 0], P[BASE + 1]), a1 = cvtpk(P[BASE + 2], P[BASE + 3]);   \
    unsigned b0 = cvtpk(P[BASE + 4], P[BASE + 5]), b1 = cvtpk(P[BASE + 6], P[BASE + 7]);                              \
    auto r0 = __builtin_amdgcn_permlane32_swap(a0, b0, false, false); auto r1 = __builtin_amdgcn_permlane32_swap(a1, b1, false, false); \
    u32x4 w = {r0[0], r1[0], r0[1], r1[1]}; OUT = *reinterpret_cast<bf16x8*>(&w); } while (0)
    PK4(p0, 0, pa0); PK4(p0, 8, pa1); PK4(p1, 0, pa2); PK4(p1, 8, pa3);
#undef PK4
}
template <bool BIAS, bool ADDREF>
__device__ __forceinline__ void partialSM_fix(f32x16& p0, f32x16& p1, const char* pkl, int hi, float pq, float cneg, float negref) {
    if constexpr (BIAS) {
#pragma unroll
        for (int i = 0; i < 4; ++i) {
            const f32x4 k0 = *(const f32x4*)(pkl + (8 * i + 4 * hi) * 4), k1 = *(const f32x4*)(pkl + (32 + 8 * i + 4 * hi) * 4);
#pragma unroll
            for (int j = 0; j < 4; ++j) { p0[4 * i + j] = fmaf(fabsf(pq - k0[j]), cneg, p0[4 * i + j]); p1[4 * i + j] = fmaf(fabsf(pq - k1[j]), cneg, p1[4 * i + j]); }
        }
    }
    if constexpr (ADDREF) {
#pragma unroll
        for (int r = 0; r < 16; ++r) { p0[r] += negref; p1[r] += negref; }
    }
#pragma unroll
    for (int r = 0; r < 16; ++r) p0[r] = __builtin_amdgcn_exp2f(p0[r]);
}
__device__ __forceinline__ void finishSM_fix(f32x16& p0, f32x16& p1, float& l_reg, bf16x8& pa0, bf16x8& pa1, bf16x8& pa2, bf16x8& pa3) {
#pragma unroll
    for (int r = 0; r < 16; ++r) p1[r] = __builtin_amdgcn_exp2f(p1[r]);
    float ps = 0;
#pragma unroll
    for (int r = 0; r < 16; ++r) ps += p0[r];
#pragma unroll
    for (int r = 0; r < 16; ++r) ps += p1[r];
    l_reg += ps;
#define PK4(P, BASE, OUT) do { unsigned a0 = cvtpk(P[BASE + 0], P[BASE + 1]), a1 = cvtpk(P[BASE + 2], P[BASE + 3]);   \
    unsigned b0 = cvtpk(P[BASE + 4], P[BASE + 5]), b1 = cvtpk(P[BASE + 6], P[BASE + 7]);                              \
    auto r0 = __builtin_amdgcn_permlane32_swap(a0, b0, false, false); auto r1 = __builtin_amdgcn_permlane32_swap(a1, b1, false, false); \
    u32x4 w = {r0[0], r1[0], r0[1], r1[1]}; OUT = *reinterpret_cast<bf16x8*>(&w); } while (0)
    PK4(p0, 0, pa0); PK4(p0, 8, pa1); PK4(p1, 0, pa2); PK4(p1, 8, pa3);
#undef PK4
}
template <bool HASKR>
__device__ __forceinline__ void qkt(f32x16& p0, f32x16& p1, const char* buf, const bf16x8* qr, int r32, int hi, const f32x16& cinit) {
    p0 = cinit; p1 = cinit;
    const char* kb = buf + KN_OFF + r32 * 144 + hi * 16;
#pragma unroll
    for (int d0 = 0; d0 < 4; ++d0) {
        const bf16x8 b0 = *reinterpret_cast<const bf16x8*>(kb + d0 * 32);
        const bf16x8 b1 = *reinterpret_cast<const bf16x8*>(kb + 32 * 144 + d0 * 32);
        p0 = __builtin_amdgcn_mfma_f32_32x32x16_bf16(b0, qr[d0], p0, 0, 0, 0);
        p1 = __builtin_amdgcn_mfma_f32_32x32x16_bf16(b1, qr[d0], p1, 0, 0, 0);
    }
    if constexpr (HASKR) {
        const char* kr = buf + KR_OFF + r32 * 80 + hi * 16;
#pragma unroll
        for (int d0 = 0; d0 < 2; ++d0) {
            const bf16x8 b0 = *reinterpret_cast<const bf16x8*>(kr + d0 * 32);
            const bf16x8 b1 = *reinterpret_cast<const bf16x8*>(kr + 32 * 80 + d0 * 32);
            p0 = __builtin_amdgcn_mfma_f32_32x32x16_bf16(b0, qr[4 + d0], p0, 0, 0, 0);
            p1 = __builtin_amdgcn_mfma_f32_32x32x16_bf16(b1, qr[4 + d0], p1, 0, 0, 0);
        }
    }
}
template <int DVB, int D0> __device__ __forceinline__ void pv_one(f32x16& od, int vb, bf16x8 pa0, bf16x8 pa1, bf16x8 pa2, bf16x8 pa3) {
    constexpr int KS = 2 * DVB * 512, HF = DVB * 512, B0 = D0 * 512;
    const s16x4 l0 = tr_read<B0>(vb), h0 = tr_read<B0 + HF>(vb), l1 = tr_read<B0 + KS>(vb), h1 = tr_read<B0 + KS + HF>(vb);
    const s16x4 l2 = tr_read<B0 + 2 * KS>(vb), h2 = tr_read<B0 + 2 * KS + HF>(vb), l3 = tr_read<B0 + 3 * KS>(vb), h3 = tr_read<B0 + 3 * KS + HF>(vb);
    asm volatile("s_waitcnt lgkmcnt(0)" ::: "memory"); SBAR();
#define PK(L, H) (bf16x8){L[0], L[1], L[2], L[3], H[0], H[1], H[2], H[3]}
    od = __builtin_amdgcn_mfma_f32_32x32x16_bf16(pa0, PK(l0, h0), od, 0, 0, 0);
    od = __builtin_amdgcn_mfma_f32_32x32x16_bf16(pa1, PK(l1, h1), od, 0, 0, 0);
    od = __builtin_amdgcn_mfma_f32_32x32x16_bf16(pa2, PK(l2, h2), od, 0, 0, 0);
    od = __builtin_amdgcn_mfma_f32_32x32x16_bf16(pa3, PK(l3, h3), od, 0, 0, 0);
#undef PK
}
template <int DVB> __device__ __forceinline__ void pv_all(f32x16* o, int vb, bf16x8 pa0, bf16x8 pa1, bf16x8 pa2, bf16x8 pa3) {
    pv_one<DVB, 0>(o[0], vb, pa0, pa1, pa2, pa3); pv_one<DVB, 1>(o[1], vb, pa0, pa1, pa2, pa3);
    if constexpr (DVB == 4) { pv_one<DVB, 2>(o[2], vb, pa0, pa1, pa2, pa3); pv_one<DVB, 3>(o[3], vb, pa0, pa1, pa2, pa3); }
}

template <int DVB, bool HASKR, bool BIAS, int SD, bool FIX, bool CINIT>
__device__ __forceinline__ void attn_pass(const bf16* __restrict__ Qrow, const bf16* __restrict__ Kn, int ldk, const bf16* __restrict__ Kr,
                                          const bf16* __restrict__ Vh, int ldv, const int* __restrict__ posk, float pq, float cneg, char* lds, f32x16 (&o)[DVB], const int tid, const int t0, const int NT, const float negref) {
    constexpr int DQB = HASKR ? 6 : 4;
    const int wid = tid >> 6, lane = tid & 63, r32 = lane & 31, hi = lane >> 5;
    float* wsf = (float*)(lds + WSF_OFF) + wid * 64; float* li_l = wsf; float* al_l = wsf + 32;
    float m_reg = -1e30f, l_reg = 0.f;
#pragma unroll
    for (int d = 0; d < DVB; ++d) o[d] = f32x16{};
    bf16x8 qr[DQB];
#pragma unroll
    for (int d0 = 0; d0 < DQB; ++d0) qr[d0] = *reinterpret_cast<const bf16x8*>(Qrow + d0 * 16);
    const int kn_r = tid >> 3, kn_c = (tid & 7) * 8, kn_st = kn_r * 144 + kn_c * 2;
    const int kr_r = (tid >> 2) & 63, kr_c = (tid & 3) * 8, kr_st = kr_r * 80 + kr_c * 2;
    const int v4_r = tid >> 4, v4_c = (tid & 15) * 8;
    const int vst0 = (DVB == 2) ? v_st<DVB>(kn_r, kn_c) : v_st<DVB>(v4_r, v4_c), vst1 = (DVB == 2) ? 0 : v_st<DVB>(32 + v4_r, v4_c);
    const int vb0 = (int)(uintptr_t)(lds + V_OFF) + v_rd_base(lane);
    struct Slot { bf16x8 kn, kr, v0, v1; float pk; } sr_[SD];
#define SLOAD(i, k0) do { sr_[i].kn = *reinterpret_cast<const bf16x8*>(Kn + (size_t)((k0) + kn_r) * ldk + kn_c); \
    if constexpr (HASKR) sr_[i].kr = *reinterpret_cast<const bf16x8*>(Kr + (size_t)((k0) + kr_r) * 32 + kr_c); \
    if constexpr (DVB == 2) sr_[i].v0 = *reinterpret_cast<const bf16x8*>(Vh + (size_t)((k0) + kn_r) * ldv + kn_c); \
    else { sr_[i].v0 = *reinterpret_cast<const bf16x8*>(Vh + (size_t)((k0) + v4_r) * ldv + v4_c); sr_[i].v1 = *reinterpret_cast<const bf16x8*>(Vh + (size_t)((k0) + 32 + v4_r) * ldv + v4_c); } \
    if constexpr (BIAS) sr_[i].pk = (float)posk[(k0) + (tid & 63)]; } while (0)
#define SWRITE(boff, i) do { char* bb_ = lds + (boff); *reinterpret_cast<bf16x8*>(bb_ + KN_OFF + kn_st) = sr_[i].kn; \
    if constexpr (HASKR) { if (tid < 256) *reinterpret_cast<bf16x8*>(bb_ + KR_OFF + kr_st) = sr_[i].kr; } \
    *reinterpret_cast<bf16x8*>(bb_ + V_OFF + vst0) = sr_[i].v0; \
    if constexpr (DVB == 4) *reinterpret_cast<bf16x8*>(bb_ + V_OFF + vst1) = sr_[i].v1; \
    if constexpr (BIAS) { if (tid < 64) *reinterpret_cast<float*>(bb_ + PK_OFF + tid * 4) = sr_[i].pk; } } while (0)
#define RESC(a) do { if (__any((a) < 1.f)) { if (hi == 0) al_l[r32] = (a); asm volatile("s_waitcnt lgkmcnt(0)" ::: "memory"); \
    _Pragma("unroll") for (int d = 0; d < DVB; ++d) _Pragma("unroll") for (int r = 0; r < 16; ++r) o[d][r] *= al_l[crow(r, hi)]; } } while (0)
    f32x16 pA0, pA1, pB0, pB1; float alA = 1.f, alB = 1.f; bf16x8 pa0, pa1, pa2, pa3;
    f32x16 cinit = f32x16{};
    if constexpr (FIX && CINIT) {
#pragma unroll
        for (int r = 0; r < 16; ++r) cinit[r] = negref;
        asm volatile("" : "+v"(cinit));
    }
#define SMP(P0, P1, AL, BUFP) do { if constexpr (FIX) partialSM_fix<BIAS, !CINIT>(P0, P1, (BUFP) + PK_OFF, hi, pq, cneg, negref); else partialSM<BIAS>(P0, P1, m_reg, AL, (BUFP) + PK_OFF, hi, pq, cneg); } while (0)
#define SMF(P0, P1, AL) do { if constexpr (FIX) finishSM_fix(P0, P1, l_reg, pa0, pa1, pa2, pa3); else finishSM(P0, P1, AL, l_reg, pa0, pa1, pa2, pa3); } while (0)
#define RESCX(AL) do { if constexpr (!FIX) RESC(AL); } while (0)
    int oV = 0, oK = BUF, oW = 2 * BUF;
#define ROT() do { const int t_ = oV; oV = oK; oK = oW; oW = t_; } while (0)
#define ITER(PX0, PX1, ALX, PY0, PY1, ALY, i, PAR) do { \
        SBAR(); qkt<HASKR>(PY0, PY1, lds + oK, qr, r32, hi, cinit); SMF(PX0, PX1, ALX); SBAR(); \
        if constexpr (SD == 2) { if ((i) + 3 < NT) SLOAD(1 - (PAR), (t0 + (i) + 3) * 64); } else { if ((i) + 2 < NT) SLOAD(0, (t0 + (i) + 2) * 64); } SBAR(); \
        pv_all<DVB>(o, vb0 + oV, pa0, pa1, pa2, pa3); SMP(PY0, PY1, ALY, lds + oK); RESCX(ALY); \
        if ((i) + 2 < NT) SWRITE(oW, (SD == 2) ? (PAR) : 0); \
        __syncthreads(); ROT(); } while (0)
    SLOAD(0, t0 * 64); SWRITE(0, 0);
    SLOAD(SD - 1, (t0 + 1) * 64); SWRITE(BUF, SD - 1);
    if constexpr (SD == 2) if (2 < NT) SLOAD(0, (t0 + 2) * 64);
    __syncthreads();
    qkt<HASKR>(pA0, pA1, lds, qr, r32, hi, cinit); SMP(pA0, pA1, alA, lds); RESCX(alA);
    for (int i = 0; i + 2 < NT; i += 2) {
        ITER(pA0, pA1, alA, pB0, pB1, alB, i, 0);
        ITER(pB0, pB1, alB, pA0, pA1, alA, i + 1, 1);
    }
    ITER(pA0, pA1, alA, pB0, pB1, alB, NT - 2, 0);
    SMF(pB0, pB1, alB); SBAR();
    pv_all<DVB>(o, vb0 + oV, pa0, pa1, pa2, pa3);
#undef ITER
#undef ROT
    if constexpr (FIX) l_reg = add_xor32(l_reg);
    if (hi == 0) li_l[r32] = l_reg; asm volatile("s_waitcnt lgkmcnt(0)" ::: "memory");
#pragma unroll
    for (int r = 0; r < 16; ++r) { const float rl = __builtin_amdgcn_rcpf(li_l[crow(r, hi)]);
#pragma unroll
        for (int d = 0; d < DVB; ++d) o[d][r] *= rl; }
    __syncthreads();
#undef SLOAD
#undef SWRITE
#undef RESC
#undef SMP
#undef SMF
#undef RESCX
}

__device__ __forceinline__ void attn_mla2(const bf16* __restrict__ Q0, const bf16* __restrict__ Q1, const bf16* __restrict__ Kn, const bf16* __restrict__ Kr, const bf16* __restrict__ Vh,
                                          char* lds, f32x16 (&o)[2][2], const int tid, const float nr0, const float nr1) {
    const int wid = tid >> 6, lane = tid & 63, r32 = lane & 31, hi = lane >> 5;
    float* wsf = (float*)(lds + WSF_OFF) + wid * 64;
    float l0 = 0.f, l1 = 0.f;
#pragma unroll
    for (int rb = 0; rb < 2; ++rb)
#pragma unroll
        for (int d = 0; d < 2; ++d) o[rb][d] = f32x16{};
    bf16x8 q0[6], q1[6];
#pragma unroll
    for (int d0 = 0; d0 < 6; ++d0) { q0[d0] = *reinterpret_cast<const bf16x8*>(Q0 + d0 * 16); q1[d0] = *reinterpret_cast<const bf16x8*>(Q1 + d0 * 16); }
    const int kn_r = tid >> 3, kn_c = (tid & 7) * 8, kn_st = kn_r * 144 + kn_c * 2;
    const int kr_r = (tid >> 2) & 63, kr_c = (tid & 3) * 8, kr_st = kr_r * 80 + kr_c * 2;
    const int vst0 = v_st<2>(kn_r, kn_c);
    const int vb0 = (int)(uintptr_t)(lds + V_OFF) + v_rd_base(lane);
    bf16x8 s_kn, s_kr, s_v;
#define SLOAD2(k0) do { s_kn = *reinterpret_cast<const bf16x8*>(Kn + (size_t)((k0) + kn_r) * 1024 + kn_c); s_kr = *reinterpret_cast<const bf16x8*>(Kr + (size_t)((k0) + kr_r) * 32 + kr_c); \
    s_v = *reinterpret_cast<const bf16x8*>(Vh + (size_t)((k0) + kn_r) * 1024 + kn_c); } while (0)
#define SWRITE2(boff) do { char* bb_ = lds + (boff); *reinterpret_cast<bf16x8*>(bb_ + KN_OFF + kn_st) = s_kn; if (tid < 256) *reinterpret_cast<bf16x8*>(bb_ + KR_OFF + kr_st) = s_kr; \
    *reinterpret_cast<bf16x8*>(bb_ + V_OFF + vst0) = s_v; } while (0)
#define PK4(P, BASE, OUT) do { unsigned a0 = cvtpk(P[BASE + 0], P[BASE + 1]), a1 = cvtpk(P[BASE + 2], P[BASE + 3]);   \
    unsigned b0 = cvtpk(P[BASE + 4], P[BASE + 5]), b1 = cvtpk(P[BASE + 6], P[BASE + 7]);                              \
    auto r0 = __builtin_amdgcn_permlane32_swap(a0, b0, false, false); auto r1 = __builtin_amdgcn_permlane32_swap(a1, b1, false, false); \
    u32x4 w = {r0[0], r1[0], r0[1], r1[1]}; OUT = *reinterpret_cast<bf16x8*>(&w); } while (0)
    constexpr int NT = SEQ / 64;
    SLOAD2(0); SWRITE2(0); __syncthreads();
    int cur = 0;
    for (int t = 0; t < NT; ++t) {
        const char* buf = lds + cur;
        f32x16 pa0 = f32x16{}, pa1 = f32x16{}, pb0 = f32x16{}, pb1 = f32x16{};
        {
            const char* kb = buf + KN_OFF + r32 * 144 + hi * 16; const char* kr = buf + KR_OFF + r32 * 80 + hi * 16;
#define KLD0(D0) ((D0) < 4 ? *reinterpret_cast<const bf16x8*>(kb + (D0) * 32) : *reinterpret_cast<const bf16x8*>(kr + ((D0) - 4) * 32))
#define KLD1(D0) ((D0) < 4 ? *reinterpret_cast<const bf16x8*>(kb + 32 * 144 + (D0) * 32) : *reinterpret_cast<const bf16x8*>(kr + 32 * 80 + ((D0) - 4) * 32))
            bf16x8 c0 = KLD0(0), c1 = KLD1(0);
#pragma unroll
            for (int d0 = 0; d0 < 6; ++d0) {
                bf16x8 n0 = c0, n1 = c1;
                if (d0 + 1 < 6) { n0 = KLD0(d0 + 1); n1 = KLD1(d0 + 1); }
                pa0 = __builtin_amdgcn_mfma_f32_32x32x16_bf16(c0, q0[d0], pa0, 0, 0, 0); pb0 = __builtin_amdgcn_mfma_f32_32x32x16_bf16(c0, q1[d0], pb0, 0, 0, 0);
                pa1 = __builtin_amdgcn_mfma_f32_32x32x16_bf16(c1, q0[d0], pa1, 0, 0, 0); pb1 = __builtin_amdgcn_mfma_f32_32x32x16_bf16(c1, q1[d0], pb1, 0, 0, 0);
                SBAR(); c0 = n0; c1 = n1;
            }
#undef KLD0
#undef KLD1
        }
        if (t + 1 < NT) SLOAD2((t + 1) * 64);
        bf16x8 fa0, fa1, fa2, fa3, fb0, fb1, fb2, fb3;
        {   float ps = 0.f;
#pragma unroll
            for (int r = 0; r < 16; ++r) { pa0[r] = __builtin_amdgcn_exp2f(pa0[r]); pa1[r] = __builtin_amdgcn_exp2f(pa1[r]);     ps += pa0[r] + pa1[r]; }
            l0 += ps; PK4(pa0, 0, fa0); PK4(pa0, 8, fa1); PK4(pa1, 0, fa2); PK4(pa1, 8, fa3); }
        {   float ps = 0.f;
#pragma unroll
            for (int r = 0; r < 16; ++r) { pb0[r] = __builtin_amdgcn_exp2f(pb0[r]); pb1[r] = __builtin_amdgcn_exp2f(pb1[r]); ps += pb0[r] + pb1[r]; }
            l1 += ps; PK4(pb0, 0, fb0); PK4(pb0, 8, fb1); PK4(pb1, 0, fb2); PK4(pb1, 8, fb3); }
        {   const int vb = vb0 + cur;
#define PV2(D0) do { constexpr int KS = 2 * 2 * 512, HF = 2 * 512, B0 = (D0) * 512; \
            const s16x4 l0_ = tr_read<B0>(vb), h0_ = tr_read<B0 + HF>(vb), l1_ = tr_read<B0 + KS>(vb), h1_ = tr_read<B0 + KS + HF>(vb); \
            const s16x4 l2_ = tr_read<B0 + 2 * KS>(vb), h2_ = tr_read<B0 + 2 * KS + HF>(vb), l3_ = tr_read<B0 + 3 * KS>(vb), h3_ = tr_read<B0 + 3 * KS + HF>(vb); \
            asm volatile("s_waitcnt lgkmcnt(0)" ::: "memory"); SBAR(); \
            const bf16x8 v0_ = (bf16x8){l0_[0], l0_[1], l0_[2], l0_[3], h0_[0], h0_[1], h0_[2], h0_[3]}, v1_ = (bf16x8){l1_[0], l1_[1], l1_[2], l1_[3], h1_[0], h1_[1], h1_[2], h1_[3]}; \
            const bf16x8 v2_ = (bf16x8){l2_[0], l2_[1], l2_[2], l2_[3], h2_[0], h2_[1], h2_[2], h2_[3]}, v3_ = (bf16x8){l3_[0], l3_[1], l3_[2], l3_[3], h3_[0], h3_[1], h3_[2], h3_[3]}; \
            o[0][D0] = __builtin_amdgcn_mfma_f32_32x32x16_bf16(fa0, v0_, o[0][D0], 0, 0, 0); o[1][D0] = __builtin_amdgcn_mfma_f32_32x32x16_bf16(fb0, v0_, o[1][D0], 0, 0, 0); \
            o[0][D0] = __builtin_amdgcn_mfma_f32_32x32x16_bf16(fa1, v1_, o[0][D0], 0, 0, 0); o[1][D0] = __builtin_amdgcn_mfma_f32_32x32x16_bf16(fb1, v1_, o[1][D0], 0, 0, 0); \
            o[0][D0] = __builtin_amdgcn_mfma_f32_32x32x16_bf16(fa2, v2_, o[0][D0], 0, 0, 0); o[1][D0] = __builtin_amdgcn_mfma_f32_32x32x16_bf16(fb2, v2_, o[1][D0], 0, 0, 0); \
            o[0][D0] = __builtin_amdgcn_mfma_f32_32x32x16_bf16(fa3, v3_, o[0][D0], 0, 0, 0); o[1][D0] = __builtin_amdgcn_mfma_f32_32x32x16_bf16(fb3, v3_, o[1][D0], 0, 0, 0); } while (0)
            PV2(0); PV2(1);
#undef PV2
        }
        if (t + 1 < NT) {
            int tw = tid; asm volatile("" : "+v"(tw));
            char* bb_ = lds + (BUF - cur);
            *reinterpret_cast<bf16x8*>(bb_ + KN_OFF + (tw >> 3) * 144 + (tw & 7) * 16) = s_kn;
            if (tw < 256) *reinterpret_cast<bf16x8*>(bb_ + KR_OFF + ((tw >> 2) & 63) * 80 + (tw & 3) * 16) = s_kr;
            *reinterpret_cast<bf16x8*>(bb_ + V_OFF + v_st<2>(tw >> 3, (tw & 7) * 8)) = s_v;
        }
        __syncthreads();
        cur = BUF - cur;
    }
    l0 = add_xor32(l0); l1 = add_xor32(l1);
    if (hi == 0) { wsf[r32] = l0; wsf[32 + r32] = l1; } asm volatile("s_waitcnt lgkmcnt(0)" ::: "memory");
#pragma unroll
    for (int r = 0; r < 16; ++r) { const float ra = __builtin_amdgcn_rcpf(wsf[crow(r, hi)]), rb = __builtin_amdgcn_rcpf(wsf[32 + crow(r, hi)]);
#pragma unroll
        for (int d = 0; d < 2; ++d) { o[0][d][r] *= ra; o[1][d][r] *= rb; } }
    __syncthreads();
#undef SLOAD2
#undef SWRITE2
#undef PK4
}
__device__ __forceinline__ void attn_diff1(const bf16* __restrict__ Qrow, const bf16* __restrict__ Kn, const bf16* __restrict__ Vh, const int* __restrict__ posk, const float pq, const float cneg,
                                           char* lds, f32x16 (&o)[4], const int tid, const int t0, const int NT, const float negref) {
    const int wid = tid >> 6, lane = tid & 63, r32 = lane & 31, hi = lane >> 5;
    float* wsf = (float*)(lds + WSF_OFF) + wid * 64;
    float l_reg = 0.f;
#pragma unroll
    for (int d = 0; d < 4; ++d) o[d] = f32x16{};
    bf16x8 qr[4];
#pragma unroll
    for (int d0 = 0; d0 < 4; ++d0) qr[d0] = *reinterpret_cast<const bf16x8*>(Qrow + d0 * 16);
    const int kn_r = tid >> 3, kn_c = (tid & 7) * 8, kn_st = kn_r * 144 + kn_c * 2;
    const int v4_r = tid >> 4, v4_c = (tid & 15) * 8;
    const int vst0 = v_st<4>(v4_r, v4_c), vst1 = v_st<4>(32 + v4_r, v4_c);
    const int vb0 = (int)(uintptr_t)(lds + V_OFF) + v_rd_base(lane);
    bf16x8 s_kn, s_v0, s_v1; float s_pk;
#define SLOADD(k0) do { s_kn = *reinterpret_cast<const bf16x8*>(Kn + (size_t)((k0) + kn_r) * 1024 + kn_c); s_v0 = *reinterpret_cast<const bf16x8*>(Vh + (size_t)((k0) + v4_r) * 1024 + v4_c); \
    s_v1 = *reinterpret_cast<const bf16x8*>(Vh + (size_t)((k0) + 32 + v4_r) * 1024 + v4_c); s_pk = (float)posk[(k0) + (tid & 63)]; } while (0)
#define SWRITED(boff) do { char* bb_ = lds + (boff); *reinterpret_cast<bf16x8*>(bb_ + KN_OFF + kn_st) = s_kn; *reinterpret_cast<bf16x8*>(bb_ + V_OFF + vst0) = s_v0; \
    *reinterpret_cast<bf16x8*>(bb_ + V_OFF + vst1) = s_v1; if (tid < 64) *reinterpret_cast<float*>(bb_ + PK_OFF + tid * 4) = s_pk; } while (0)
#define PK4(P, BASE, OUT) do { unsigned a0 = cvtpk(P[BASE + 0], P[BASE + 1]), a1 = cvtpk(P[BASE + 2], P[BASE + 3]);   \
    unsigned b0 = cvtpk(P[BASE + 4], P[BASE + 5]), b1 = cvtpk(P[BASE + 6], P[BASE + 7]);                              \
    auto r0 = __builtin_amdgcn_permlane32_swap(a0, b0, false, false); auto r1 = __builtin_amdgcn_permlane32_swap(a1, b1, false, false); \
    u32x4 w = {r0[0], r1[0], r0[1], r1[1]}; OUT = *reinterpret_cast<bf16x8*>(&w); } while (0)
    SLOADD(t0 * 64); SWRITED(0); __syncthreads();
    int cur = 0;
    for (int t = 0; t < NT; ++t) {
        const char* buf = lds + cur;
        f32x16 p0 = f32x16{}, p1 = f32x16{};
        {   const char* kb = buf + KN_OFF + r32 * 144 + hi * 16;
            bf16x8 c0 = *reinterpret_cast<const bf16x8*>(kb), c1 = *reinterpret_cast<const bf16x8*>(kb + 32 * 144);
#pragma unroll
            for (int d0 = 0; d0 < 4; ++d0) {
                bf16x8 n0 = c0, n1 = c1;
                if (d0 + 1 < 4) { n0 = *reinterpret_cast<const bf16x8*>(kb + (d0 + 1) * 32); n1 = *reinterpret_cast<const bf16x8*>(kb + 32 * 144 + (d0 + 1) * 32); }
                p0 = __builtin_amdgcn_mfma_f32_32x32x16_bf16(c0, qr[d0], p0, 0, 0, 0); p1 = __builtin_amdgcn_mfma_f32_32x32x16_bf16(c1, qr[d0], p1, 0, 0, 0);
                c0 = n0; c1 = n1;
            }
        }
        if (t + 1 < NT) SLOADD((t0 + t + 1) * 64);
        const int vb = vb0 + cur;
#define VRD(D0, L, H) do { constexpr int KS = 2 * 4 * 512, HF = 4 * 512, B0 = (D0) * 512; \
            L[0] = tr_read<B0>(vb); H[0] = tr_read<B0 + HF>(vb); L[1] = tr_read<B0 + KS>(vb); H[1] = tr_read<B0 + KS + HF>(vb); \
            L[2] = tr_read<B0 + 2 * KS>(vb); H[2] = tr_read<B0 + 2 * KS + HF>(vb); L[3] = tr_read<B0 + 3 * KS>(vb); H[3] = tr_read<B0 + 3 * KS + HF>(vb); } while (0)
#define VFR(L, H, k) (bf16x8){L[k][0], L[k][1], L[k][2], L[k][3], H[k][0], H[k][1], H[k][2], H[k][3]}
#define PVM(D0, L, H) do { o[D0] = __builtin_amdgcn_mfma_f32_32x32x16_bf16(fa0, VFR(L, H, 0), o[D0], 0, 0, 0); o[D0] = __builtin_amdgcn_mfma_f32_32x32x16_bf16(fa1, VFR(L, H, 1), o[D0], 0, 0, 0); \
            o[D0] = __builtin_amdgcn_mfma_f32_32x32x16_bf16(fa2, VFR(L, H, 2), o[D0], 0, 0, 0); o[D0] = __builtin_amdgcn_mfma_f32_32x32x16_bf16(fa3, VFR(L, H, 3), o[D0], 0, 0, 0); } while (0)
        s16x4 la[4], ha[4], lb[4], hb[4];
        VRD(0, la, ha); VRD(1, lb, hb);
        {   const char* pkl = buf + PK_OFF;
#pragma unroll
            for (int i = 0; i < 4; ++i) {
                const f32x4 k0 = *(const f32x4*)(pkl + (8 * i + 4 * hi) * 4), k1 = *(const f32x4*)(pkl + (32 + 8 * i + 4 * hi) * 4);
#pragma unroll
                for (int q = 0; q < 4; ++q) { p0[4 * i + q] = fmaf(fabsf(pq - k0[q]), cneg, p0[4 * i + q]); p1[4 * i + q] = fmaf(fabsf(pq - k1[q]), cneg, p1[4 * i + q]); }
            }
        }
        bf16x8 fa0, fa1, fa2, fa3;
        {   float ps = 0.f;
#pragma unroll
            for (int r = 0; r < 16; ++r) { p0[r] = __builtin_amdgcn_exp2f(p0[r]); p1[r] = __builtin_amdgcn_exp2f(p1[r]);     ps += p0[r] + p1[r]; }
            l_reg += ps; PK4(p0, 0, fa0); PK4(p0, 8, fa1); PK4(p1, 0, fa2); PK4(p1, 8, fa3); }
        asm volatile("s_waitcnt lgkmcnt(0)" ::: "memory"); SBAR();
        PVM(0, la, ha); SBAR();
        VRD(2, la, ha);
        SBAR(); PVM(1, lb, hb); SBAR();
        VRD(3, lb, hb);
        asm volatile("s_waitcnt lgkmcnt(8)" ::: "memory"); SBAR();
        PVM(2, la, ha);
        asm volatile("s_waitcnt lgkmcnt(0)" ::: "memory"); SBAR();
        PVM(3, lb, hb);
#undef VRD
#undef VFR
#undef PVM
        if (t + 1 < NT) SWRITED(BUF - cur);
        __syncthreads();
        cur = BUF - cur;
    }
    l_reg = add_xor32(l_reg);
    if (hi == 0) wsf[r32] = l_reg; asm volatile("s_waitcnt lgkmcnt(0)" ::: "memory");
#pragma unroll
    for (int r = 0; r < 16; ++r) { const float rl = __builtin_amdgcn_rcpf(wsf[crow(r, hi)]);
#pragma unroll
        for (int d = 0; d < 4; ++d) o[d][r] *= rl; }
    __syncthreads();
#undef SLOADD
#undef SWRITED
#undef PK4
}
}

#define XB_TMO      128
#define XB_XCNT(j)  (256  + 64 * (j))
#define XB_XSUB(j)  (1280 + 64 * (j))
#define XB_XGEN(j)  (2304 + 64 * (j))
#define XB_TOP      3328
#define XB_TOPGEN   3392
#define XCD_BAR_WORDS 3456
#define XB_SPIN_CAP (1u << 18)

__device__ __forceinline__ unsigned xb_ld(unsigned* p)              { return __hip_atomic_load(p, __ATOMIC_RELAXED, __HIP_MEMORY_SCOPE_AGENT); }
__device__ __forceinline__ unsigned xb_add(unsigned* p, unsigned v) { return __hip_atomic_fetch_add(p, v, __ATOMIC_RELAXED, __HIP_MEMORY_SCOPE_AGENT); }
__device__ __forceinline__ unsigned xb_xcc_id() { return (unsigned)__builtin_amdgcn_s_getreg((3 << 11) | 20) & 0xFu; }
#define XB_SPIN(cond, bar) do { unsigned _sp = 0; while (cond) { __builtin_amdgcn_s_sleep(1); \
    if ((++_sp & 255u) == 0u) { if (xb_ld(&(bar)[XB_TMO])) break; if (_sp > XB_SPIN_CAP) { atomicAdd(&(bar)[XB_TMO], 1u); break; } } } } while (0)

struct XcdBarrier {
    unsigned* bar; unsigned x;
    volatile LAS unsigned* st;
};

__device__ __forceinline__ XcdBarrier xcd_barrier_post(unsigned* bar, volatile LAS unsigned* st) {
    XcdBarrier b; b.bar = bar; b.x = xb_xcc_id(); b.st = st;
    if (threadIdx.x == 0) (void)xb_add(&bar[XB_XCNT(b.x)], 1u);
    return b;
}
__device__ __forceinline__ void xcd_barrier_complete(unsigned* bar, unsigned x, unsigned& nloc, unsigned& nx) {
    const unsigned G = gridDim.x * gridDim.y * gridDim.z;
    unsigned sum, cnt, mine, sp = 0u;
    for (;;) {
        sum = 0u; cnt = 0u; mine = 0u;
#pragma unroll
        for (unsigned j = 0; j < 16; ++j) { const unsigned c = xb_ld(&bar[XB_XCNT(j)]); sum += c; cnt += (c > 0u) ? 1u : 0u; mine = (j == x) ? c : mine; }
        if (sum == G) break;
        __builtin_amdgcn_s_sleep(1);
        if ((++sp & 255u) == 0u) { if (xb_ld(&bar[XB_TMO])) break; if (sp > XB_SPIN_CAP) { atomicAdd(&bar[XB_TMO], 1u); break; } }
    }
    nloc = mine > 0u ? mine : 1u; nx = cnt > 0u ? cnt : 1u;
}

__device__ __forceinline__ void xcd_barrier(const XcdBarrier& b) {
    asm volatile("s_waitcnt vmcnt(0)" ::: "memory");
    __syncthreads();
    if (threadIdx.x == 0) {
        unsigned* bar = b.bar;
        __builtin_amdgcn_s_waitcnt(0);
        unsigned nloc = b.st[0], nx = b.st[1];
        if (nloc == 0u) { xcd_barrier_complete(bar, b.x, nloc, nx); b.st[0] = nloc; b.st[1] = nx; }
        const unsigned old = xb_add(&bar[XB_XSUB(b.x)], 1u);
        const unsigned gen = old / nloc;
        if (old + 1u == (gen + 1u) * nloc) {
            __builtin_amdgcn_fence(__ATOMIC_RELEASE, "agent");
            asm volatile("s_waitcnt vmcnt(0)" ::: "memory");
            const unsigned og = xb_add(&bar[XB_TOP], 1u);
            const unsigned tg = og / nx;
            if (og + 1u == (tg + 1u) * nx) xb_add(&bar[XB_TOPGEN], 1u);
            else XB_SPIN(xb_ld(&bar[XB_TOPGEN]) == tg, bar);
            __builtin_amdgcn_fence(__ATOMIC_ACQUIRE, "agent");
            xb_add(&bar[XB_XGEN(b.x)], 1u);
            asm volatile("s_waitcnt vmcnt(0)" ::: "memory");
        } else {
            XB_SPIN(xb_ld(&bar[XB_XGEN(b.x)]) == gen, bar);
            __builtin_amdgcn_fence(__ATOMIC_ACQUIRE, "agent");
            asm volatile("s_waitcnt vmcnt(0)" ::: "memory");
        }
    }
    __syncthreads();
}

struct Args {
    const float* x; const float* c; const int* pos; const float* ada_w; const float* ada_b; const float* norm_g;
    const float* mla_w_in; const float* mla_qg; const float* mla_wq; const float* mla_kvg; const float* mla_wkv; const float* mla_wo;
    const float* diff_w_in; const float* lq1; const float* lk1; const float* lq2; const float* lk2; const float* head_g; const float* diff_wo; const float* final_g;
    float* out; unsigned char* ws;
};

__device__ __forceinline__ unsigned f2bf(float f) { unsigned u = __builtin_bit_cast(unsigned, f); return (u + 0x7fffu + ((u >> 16) & 1u)) >> 16; }
__device__ __forceinline__ unsigned pk2(float lo, float hi) { return f2bf(lo) | (f2bf(hi) << 16); }

__device__ __forceinline__ void transpose_item(const float* W, const float* gain, int K, int N, bf16* WT, LAS float* scr, int item, int lane) {
    const int nblk = N / 32, kb = item / nblk, nb = item % nblk, k0 = 64 * kb, n0 = 32 * nb;
    f32x4 wv[8];
#pragma unroll
    for (int i = 0; i < 8; ++i) wv[i] = __builtin_nontemporal_load((const f32x4*)(W + (size_t)(k0 + 8 * i + (lane >> 3)) * N + n0 + (lane & 7) * 4));
#pragma unroll
    for (int i = 0; i < 8; ++i) { const int kk = 8 * i + (lane >> 3); f32x4 w = wv[i]; if (gain) w = w * gain[k0 + kk]; LAS float* d = scr + kk * 33 + (lane & 7) * 4; d[0] = w[0]; d[1] = w[1]; d[2] = w[2]; d[3] = w[3]; }
    asm volatile("s_waitcnt lgkmcnt(0)" ::: "memory");
    const int c = lane & 7;
#pragma unroll
    for (int j = 0; j < 4; ++j) { const int n = (lane >> 3) + 8 * j; const LAS float* s = scr + (8 * c) * 33 + n;
        u32x4 o; o.x = pk2(s[0 * 33], s[1 * 33]); o.y = pk2(s[2 * 33], s[3 * 33]); o.z = pk2(s[4 * 33], s[5 * 33]); o.w = pk2(s[6 * 33], s[7 * 33]);
        *(u32x4*)(WT + (size_t)(n0 + n) * K + k0 + 8 * c) = o; }
    asm volatile("s_waitcnt lgkmcnt(0)" ::: "memory");
}

template <class F>
__device__ __forceinline__ void run_gemm(LAS unsigned char* lds, const bf16* A, int lda, const bf16* Bt, int N, int K, const F& f, const int tid, const int bxp, const int Gp) {
    pg8::Gemm g{A, Bt, M, N, K, lda}; pg8::StaticOrder S; S.init(M, N, Gp, bxp);
    pg8::EpiF<F> E{f};
    pg8::gemm_phase<pg8::EpiF<F>, pg8::StaticOrder, true, true>(lds, g, S, E, tid);
}

typedef const __attribute__((address_space(4))) Args KArgs;
__global__ void __launch_bounds__(512, 2) fwd_kernel(Args a) {
    extern __shared__ __attribute__((aligned(16))) unsigned char lds[];
    cg::grid_group grid = cg::this_grid();
    LAS unsigned char* ldsl = (LAS unsigned char*)lds;
    volatile LAS unsigned* bar_st = (volatile LAS unsigned*)(ldsl + 131072 + 64);
    if (threadIdx.x == 0) { bar_st[0] = 0u; bar_st[1] = 0u; }
    __syncthreads();
    const int tid = threadIdx.x, lane = tid & 63, wave = __builtin_amdgcn_readfirstlane(tid >> 6);
    const int G = gridDim.x, bx = blockIdx.x;
    const int vcu = (G % 8 == 0) ? (bx % 8) * (G / 8) + bx / 8 : bx;
    const int gw = bx * 8 + wave, ngw = G * 8;
    unsigned char* ws = a.ws;
    float* MOD = (float*)(ws + WS_MOD); float* PAR = (float*)(ws + WS_PAR); float* SSQ = (float*)(ws + WS_SSQ);
    float* RC = (float*)(ws + WS_COS); float* RS = (float*)(ws + WS_SIN);

    if (bx < 192) {
        float* cact = (float*)lds; float* red = (float*)lds + 2048;
        for (int i = tid; i < 2048; i += 512) cact[i] = silu1(a.c[i]);
        __syncthreads();
        const int l = bx / 48, cgp = bx % 48, col = tid & 63, kg = tid >> 6;
        const float* wp = a.ada_w + (size_t)l * 1024 * 3072 + (size_t)(kg * 128) * 3072 + cgp * 64 + col;
        float acc0 = 0.f, acc1 = 0.f;
#pragma unroll 16
        for (int k = 0; k < 128; ++k) { const float w = __builtin_nontemporal_load(wp + (size_t)k * 3072); acc0 = fmaf(cact[kg * 128 + k], w, acc0); acc1 = fmaf(cact[1024 + kg * 128 + k], w, acc1); }
        red[(kg * 2 + 0) * 64 + col] = acc0; red[(kg * 2 + 1) * 64 + col] = acc1;
        __syncthreads();
        if (tid < 128) { const int b = tid >> 6; float s = 0.f;
#pragma unroll
            for (int q = 0; q < 8; ++q) s += red[(q * 2 + b) * 64 + col];
            MOD[(l * 2 + b) * 3072 + cgp * 64 + col] = s + a.ada_b[l * 3072 + cgp * 64 + col]; }
        __syncthreads();
    }
    {
        LAS float* scr = (LAS float*)(ldsl + wave * 8448);
        constexpr int I_MIN = 16 * 53, I_MQ = 6 * 48, I_MKV = 4 * 64, I_O = 16 * 32, I_DIN = 16 * 128;
        constexpr int PER_J = I_MIN + I_MQ + I_MKV + I_O + I_DIN + I_O, NITEMS = 2 * PER_J;
        for (int it = gw; it < NITEMS; it += ngw) {
            const int j = it / PER_J; int r = it % PER_J;
            unsigned char* wm = ws + WS_WMLA + (size_t)j * W_MLA_SZ; unsigned char* wd = ws + WS_WDIFF + (size_t)j * W_DIFF_SZ;
            if (r < I_MIN) { transpose_item(a.mla_w_in + (size_t)j * 1024 * MLA_IN, nullptr, 1024, MLA_IN, (bf16*)(wm + W_MLA_IN), scr, r, lane); continue; } r -= I_MIN;
            if (r < I_MQ) { transpose_item(a.mla_wq + (size_t)j * 384 * 1536, a.mla_qg + j * 384, 384, 1536, (bf16*)(wm + W_MLA_Q), scr, r, lane); continue; } r -= I_MQ;
            if (r < I_MKV) { transpose_item(a.mla_wkv + (size_t)j * 256 * 2048, a.mla_kvg + j * 256, 256, 2048, (bf16*)(wm + W_MLA_KV), scr, r, lane); continue; } r -= I_MKV;
            if (r < I_O) { transpose_item(a.mla_wo + (size_t)j * 1024 * 1024, nullptr, 1024, 1024, (bf16*)(wm + W_MLA_O), scr, r, lane); continue; } r -= I_O;
            if (r < I_DIN) { transpose_item(a.diff_w_in + (size_t)j * 1024 * 4096, nullptr, 1024, 4096, (bf16*)(wd + W_DIFF_IN), scr, r, lane); continue; } r -= I_DIN;
            transpose_item(a.diff_wo + (size_t)j * 1024 * 1024, nullptr, 1024, 1024, (bf16*)(wd + W_DIFF_O), scr, r, lane);
        }
    }
    {
        const int gt = bx * 512 + tid, ngt = G * 512;
        for (int i = gt; i < M * 16; i += ngt) {
            const int row = i >> 4, fi = i & 15;
            const float inv = (float)exp2(-(double)(2 * fi) / 32.0 * 13.287712379549449);
            const float ang = (float)a.pos[row] * inv;
            const double x = (double)ang; const double n = rint(x * 0.15915494309189535); const double rr = x - n * 6.283185307179586; const double r2 = rr * rr;
            double s = 1.0, c = 1.0;
#pragma unroll
            for (int k = 12; k >= 1; --k) { s = 1.0 - r2 / (double)((2 * k) * (2 * k + 1)) * s; c = 1.0 - r2 / (double)((2 * k - 1) * (2 * k)) * c; }
            RC[i] = (float)c; RS[i] = (float)(rr * s);
        }
        for (int i = gt; i < 4 * M; i += ngt) SSQ[i] = 0.f;
        for (int i = gt; i < 3456; i += ngt) ((unsigned*)(ws + WS_BAR))[i] = 0u;
        for (int i = gt; i < (int)AUX_ZERO_WORDS; i += ngt) ((unsigned*)(ws + WS_AUX + AUX_KN2))[i] = 0u;
        if (gt < 256) { const int* pp = a.pos + (gt >> 7) * SEQ + (gt & 127) * 64; int mn = pp[0], mx = pp[0];
            for (int k = 1; k < 64; ++k) { const int v = pp[k]; mn = min(mn, v); mx = max(mx, v); }
            ((int*)(ws + WS_AUX + AUX_TMIN))[gt] = mn; ((int*)(ws + WS_AUX + AUX_TMAX))[gt] = mx; }
        for (int i = gt; i < 2 * (MLA_IN_PAD - MLA_IN) * 1024 / 2; i += ngt) {
            const int j = i / ((MLA_IN_PAD - MLA_IN) * 512), w = i % ((MLA_IN_PAD - MLA_IN) * 512);
            ((unsigned*)(ws + WS_WMLA + (size_t)j * W_MLA_SZ + W_MLA_IN + (size_t)MLA_IN * 1024 * 2))[w] = 0u;
        }
        if (gt < 2) { const int j = gt; float s1 = 0.f, s2 = 0.f;
            for (int k = 0; k < 64; ++k) { s1 += a.lq1[j * 64 + k] * a.lk1[j * 64 + k]; s2 += a.lq2[j * 64 + k] * a.lk2[j * 64 + k]; }
            const float li = 0.8f - 0.6f * expf(-0.3f * (float)(2 * j + 1));
            PAR[j] = expf(s1) - expf(s2) + li; PAR[2 + j] = li; }
    }
    grid.sync();
    const XcdBarrier xbar = xcd_barrier_post((unsigned*)(a.ws + WS_BAR), bar_st);

#define PH_BEGIN const size_t oz_ = (size_t)(unsigned)opaque_u32(0u); unsigned char* ws = a.ws + oz_; \
    asm volatile("" : "+v"(tidv)); const int tid = tidv, lane = tid & 63, wave = __builtin_amdgcn_readfirstlane(tid >> 6); (void)lane; (void)wave; (void)ws; \
    const int bxp = opaque_u32(blockIdx.x), Gp = opaque_u32(gridDim.x); (void)bxp; (void)Gp;
    int tidv = threadIdx.x;
    for (int l = 0; l < DEPTH; ++l) {
        const int j = l >> 1;
        {
            PH_BEGIN
            const float* xin = (l == 0) ? (a.x + oz_) : (a.out + oz_); const float* modl = (const float*)(ws + WS_MOD) + l * 6144; bf16* HO = (bf16*)(ws + WS_HO);
            const float* ng = (a.norm_g + oz_) + l * D;
            for (int m = bxp * 8 + wave; m < M; m += Gp * 8) {
                const f32x4* xr = (const f32x4*)(xin + (size_t)m * D) + lane; f32x4 v[4]; float s = 0.f;
#pragma unroll
                for (int q = 0; q < 4; ++q) { v[q] = __builtin_nontemporal_load(xr + 64 * q); s += dot4(v[q]); }
                const float r = rsqrtf(wave_sum(s) * (1.0f / D) + EPS);
                const float* md = modl + (m >> 13) * 3072;
#pragma unroll
                for (int q = 0; q < 4; ++q) { const int col = 4 * lane + 256 * q;
                    const f32x4 gg = *(const f32x4*)(ng + col), sh = *(const f32x4*)(md + col), sc = *(const f32x4*)(md + 1024 + col);
                    st4(HO + (size_t)m * D + col, (v[q] * r) * gg * (sc + 1.0f) + sh); }
            }
        }
        xcd_barrier(xbar);
        if ((l & 1) == 0) {
            {   PH_BEGIN
                unsigned char* wm = ws + WS_WMLA + (size_t)j * W_MLA_SZ;
                run_gemm(ldsl, (const bf16*)(ws + WS_HO), 1024, (const bf16*)(wm + W_MLA_IN), MLA_IN_PAD, 1024, E1{ws, j}, tid, bxp, Gp);
            }
            xcd_barrier(xbar);
            {   PH_BEGIN
                unsigned char* wm = ws + WS_WMLA + (size_t)j * W_MLA_SZ;
                run_gemm(ldsl, (const bf16*)(ws + WS_QL), 384, (const bf16*)(wm + W_MLA_Q), 1536, 384, E2{ws, j}, tid, bxp, Gp);
            }
            {   PH_BEGIN
                unsigned char* wm = ws + WS_WMLA + (size_t)j * W_MLA_SZ;
                run_gemm(ldsl, (const bf16*)(ws + WS_KVL), 256, (const bf16*)(wm + W_MLA_KV), 2048, 256, E3{ws, j}, tid, bxp, Gp);
            }
            xcd_barrier(xbar);
            {
                PH_BEGIN
                bf16* HO = (bf16*)(ws + WS_HO); const bf16* Qb = (const bf16*)(ws + WS_Q); const bf16* KR = (const bf16*)(ws + WS_KR);
                const bf16* Kb = (const bf16*)(ws + WS_K); const bf16* Vb = (const bf16*)(ws + WS_V); const bf16* Gb = (const bf16*)(ws + WS_G);
                const int vcup = (Gp % 8 == 0) ? (bxp % 8) * (Gp / 8) + bxp / 8 : bxp;
                for (int u = vcup; u < NB * 16 * 16; u += Gp) {
                    const int bh = u >> 4, qb = u & 15, b = bh >> 4, h = bh & 15;
                    asm volatile("" : "+v"(tidv)); const int tid = tidv, lane = tid & 63;
                    const int r32 = lane & 31, hi = lane >> 5; const size_t row0 = (size_t)b * SEQ + qb * 512 + wave * 64;
                    const bf16* qrow0 = Qb + (row0 + r32) * 1536 + h * 96 + hi * 8; const bf16* qrow1 = qrow0 + 32 * 1536;
                    float qa = 0.f, qc = 0.f;
#pragma unroll
                    for (int d0 = 0; d0 < 6; ++d0) { const att::bf16x8 v = *reinterpret_cast<const att::bf16x8*>(qrow0 + d0 * 16), w = *reinterpret_cast<const att::bf16x8*>(qrow1 + d0 * 16);
#pragma unroll
                        for (int e = 0; e < 8; ++e) { const float f = bf2f((bf16)v[e]), g2 = bf2f((bf16)w[e]); qa = fmaf(f, f, qa); qc = fmaf(g2, g2, qc); } }
                    qa = add_xor32(qa); qc = add_xor32(qc);
                    const unsigned* knm = (const unsigned*)(ws + WS_AUX + AUX_KNM) + (j * 2 + b) * 32 + h * 2; const unsigned* krm = (const unsigned*)(ws + WS_AUX + AUX_KRM) + (j * 2 + b) * 16;
                    const float kmax2 = __uint_as_float(knm[0]) + __uint_as_float(knm[1]) + __uint_as_float(krm[0]);
                    const float bnd0 = 1.02f * sqrtf(qa * kmax2) + 0.01f, bnd1 = 1.02f * sqrtf(qc * kmax2) + 0.01f;
                    volatile int* bigf = (volatile int*)(lds + 98304);
                    __syncthreads(); if (tid == 0) bigf[0] = 0; __syncthreads(); if (fmaxf(bnd0, bnd1) > 60.0f) bigf[0] = 1; __syncthreads();
                    const bf16* Kh = Kb + (size_t)b * SEQ * 1024 + h * 64; const bf16* Vh = Vb + (size_t)b * SEQ * 1024 + h * 64; const bf16* Krb = KR + (size_t)b * SEQ * 32;
                    if (bigf[0] == 0) {
                        att::f32x16 o2[2][2];
                        const bf16* qr0 = qrow0; asm volatile("" : "+v"(qr0));
                        att::attn_mla2(qr0, qr0 + 32 * 1536, Kh, Krb, Vh, (char*)lds, o2, tid, -bnd0, -bnd1);
                        asm volatile("" : "+v"(tidv));
                        const int lane_e = tidv & 63, r32e = lane_e & 31, hie = lane_e >> 5; const size_t row0e = (size_t)b * SEQ + qb * 512 + (size_t)__builtin_amdgcn_readfirstlane(tidv >> 6) * 64;
                        float* stg = (float*)lds + (size_t)__builtin_amdgcn_readfirstlane(tidv >> 6) * (32 * 68);
#pragma unroll
                        for (int rb = 0; rb < 2; ++rb) {
#pragma unroll
                            for (int r = 0; r < 16; ++r)
#pragma unroll
                                for (int d = 0; d < 2; ++d) stg[att::crow(r, hie) * 68 + d * 32 + r32e] = o2[rb][d][r];
                            asm volatile("s_waitcnt lgkmcnt(0)" ::: "memory");
#pragma unroll
                            for (int i = 0; i < 4; ++i) { const int rw = i * 8 + (lane_e >> 3), cc = (lane_e & 7) * 8;
                                const f32x4 v0 = *(const f32x4*)(stg + rw * 68 + cc), v1 = *(const f32x4*)(stg + rw * 68 + cc + 4);
                                const size_t off = (row0e + rb * 32 + rw) * 1024 + h * 64 + cc;
                                const u32x4 g = *(const u32x4*)(Gb + off);
                                const f32x4 g0 = {__uint_as_float(g.x << 16), __uint_as_float(g.x & 0xffff0000u), __uint_as_float(g.y << 16), __uint_as_float(g.y & 0xffff0000u)};
                                const f32x4 g1 = {__uint_as_float(g.z << 16), __uint_as_float(g.z & 0xffff0000u), __uint_as_float(g.w << 16), __uint_as_float(g.w & 0xffff0000u)};
                                st8(HO + off, v0 * g0, v1 * g1); }
                            asm volatile("s_waitcnt lgkmcnt(0)" ::: "memory");
                        }
                    } else {
#pragma unroll 1
                        for (int half = 0; half < 2; ++half) {
                            const size_t rw0 = (size_t)b * SEQ + qb * 512 + half * 256 + wave * 32;
                            att::f32x16 o[2];
                            att::attn_pass<2, true, false, 2, false, false>(Qb + (rw0 + r32) * 1536 + h * 96 + hi * 8, Kh, 1024, Krb, Vh, 1024, nullptr, 0.f, 0.f, (char*)lds, o, tid, 0, SEQ / 64, 0.f);
#pragma unroll
                            for (int r = 0; r < 16; ++r) { const size_t row = rw0 + att::crow(r, hi);
#pragma unroll
                                for (int d = 0; d < 2; ++d) { const size_t off = row * 1024 + h * 64 + d * 32 + r32; HO[off] = (bf16)f2bf(o[d][r] * bf2f(Gb[off])); } }
                        }
                    }
                }
            }
            xcd_barrier(xbar);
            {   PH_BEGIN
                unsigned char* wm = ws + WS_WMLA + (size_t)j * W_MLA_SZ; const float* xin = (l == 0) ? (a.x + oz_) : (a.out + oz_);
                run_gemm(ldsl, (const bf16*)(ws + WS_HO), 1024, (const bf16*)(wm + W_MLA_O), 1024, 1024, E4{ws, xin, (a.out + oz_), l}, tid, bxp, Gp);
            }
            xcd_barrier(xbar);
        } else {
            {   PH_BEGIN
                unsigned char* wd = ws + WS_WDIFF + (size_t)j * W_DIFF_SZ;
                run_gemm(ldsl, (const bf16*)(ws + WS_HO), 1024, (const bf16*)(wd + W_DIFF_IN), 4096, 1024, E5{ws, j}, tid, bxp, Gp);
            }
            xcd_barrier(xbar);
            {
                PH_BEGIN
                bf16* HO = (bf16*)(ws + WS_HO); const bf16* Qb = (const bf16*)(ws + WS_Q);
                const bf16* Kb = (const bf16*)(ws + WS_K); const bf16* Vb = (const bf16*)(ws + WS_V); const bf16* Gb = (const bf16*)(ws + WS_G);
                const float* PAR = (const float*)(ws + WS_PAR); float* STASH = (float*)(ws + WS_STASH);
                const float lam = __uint_as_float(__builtin_amdgcn_readfirstlane(__float_as_uint(PAR[j]))), omli = 1.0f - __uint_as_float(__builtin_amdgcn_readfirstlane(__float_as_uint(PAR[2 + j])));
                unsigned* CNT = (unsigned*)(ws + WS_AUX + AUX_CNT) + j * 64;
                const int* TMIN = (const int*)(ws + WS_AUX + AUX_TMIN); const int* TMAX = (const int*)(ws + WS_AUX + AUX_TMAX);
                const unsigned* KN2 = (const unsigned*)(ws + WS_AUX + AUX_KN2) + (size_t)j * 256 * 32; const unsigned* QN2 = (const unsigned*)(ws + WS_AUX + AUX_QN2) + (size_t)j * 64 * 32;
                volatile int* sm = (volatile int*)(lds + 98304); volatile unsigned long long* smask = (volatile unsigned long long*)(lds + 98304 + 64);
                for (;;) {
                    __syncthreads();
                    if (tidv == 0) sm[0] = (int)atomicAdd(CNT, 1u);
                    __syncthreads();
                    const int qi = sm[0]; if (qi >= NB * 8 * 32) break;
                    const int h = 7 - (qi >> 6), b = (qi >> 5) & 1, qb = qi & 31;
                    asm volatile("" : "+v"(tidv)); const int tid = tidv, lane = tid & 63;
                    const int r32 = lane & 31, hi = lane >> 5; const size_t row0 = (size_t)b * SEQ + qb * 256 + wave * 32;
                    const float cpos = exp2f(-(float)(h + 1)) * LOG2E, cneg = -cpos;
                    const float pq = (float)(a.pos + oz_)[row0 + r32];
                    f32x4* st = (f32x4*)(STASH + ((size_t)bxp * 512 + tid) * 64);
                    att::f32x16 o[4];
#pragma unroll 1
                    for (int c = 0; c < 2; ++c) {
                        {
                            const bf16* qd = Qb + (row0 + r32) * 1024 + h * 128 + c * 64 + hi * 8; const bf16* kd = Kb + (row0 + r32) * 1024 + h * 128 + c * 64 + hi * 8;
                            float sii = 0.f;
#pragma unroll
                            for (int d0 = 0; d0 < 4; ++d0) { const att::bf16x8 qv = *reinterpret_cast<const att::bf16x8*>(qd + d0 * 16), kv = *reinterpret_cast<const att::bf16x8*>(kd + d0 * 16);
#pragma unroll
                                for (int e = 0; e < 8; ++e) sii = fmaf(bf2f((bf16)qv[e]), bf2f((bf16)kv[e]), sii); }
                            sii = add_xor32(sii);
                            sii = fminf(sii, swz_xor<1>(sii)); sii = fminf(sii, swz_xor<2>(sii)); sii = fminf(sii, swz_xor<4>(sii)); sii = fminf(sii, swz_xor<8>(sii)); sii = fminf(sii, swz_xor<16>(sii));
                            if (lane == 0) ((volatile float*)(lds + 98304 + 128))[wave] = sii;
                        }
                        __syncthreads();
                        if (tid < 128) {
                            const volatile float* smin = (const volatile float*)(lds + 98304 + 128);
                            const float mlb = fminf(fminf(fminf(smin[0], smin[1]), fminf(smin[2], smin[3])), fminf(fminf(smin[4], smin[5]), fminf(smin[6], smin[7]))) - 0.05f;
                            const int hm2 = (h * 2 + c) * 2, t = tid;
                            const unsigned* qp = QN2 + ((size_t)b * 32 + qb) * 32 + hm2; const float qn = sqrtf(__uint_as_float(qp[0]) + __uint_as_float(qp[1]));
                            const unsigned* kp = KN2 + ((size_t)b * 128 + t) * 32 + hm2; const float kn = sqrtf(__uint_as_float(kp[0]) + __uint_as_float(kp[1]));
                            int qmin = 0x7fffffff, qmax = -0x7fffffff;
#pragma unroll
                            for (int i = 0; i < 4; ++i) { qmin = min(qmin, TMIN[b * 128 + 4 * qb + i]); qmax = max(qmax, TMAX[b * 128 + 4 * qb + i]); }
                            const int dmin = max(0, max(qmin - TMAX[b * 128 + t], TMIN[b * 128 + t] - qmax));
                            const bool keep = 1.03f * qn * kn - cpos * (float)dmin > mlb - 32.0f;
                            const unsigned long long mk = __ballot(keep);
                            float kb = qn * kn;
                            kb = fmaxf(kb, swz_xor<1>(kb)); kb = fmaxf(kb, swz_xor<2>(kb)); kb = fmaxf(kb, swz_xor<4>(kb)); kb = fmaxf(kb, swz_xor<8>(kb)); kb = fmaxf(kb, swz_xor<16>(kb));
                            { auto rr = __builtin_amdgcn_permlane32_swap(__float_as_uint(kb), __float_as_uint(kb), false, false); kb = fmaxf(__uint_as_float(rr[0]), __uint_as_float(rr[1])); }
                            if (lane == 0) { smask[tid >> 6] = mk; ((volatile float*)(lds + 98304 + 192))[tid >> 6] = kb; }
                        }
                        __syncthreads();
                        const float bnd = 1.03f * fmaxf(((volatile float*)(lds + 98304 + 192))[0], ((volatile float*)(lds + 98304 + 192))[1]) + 0.01f;
                        const unsigned long long m0 = smask[0], m1 = smask[1];
                        int t_lo = m0 ? __builtin_ctzll(m0) : 64 + __builtin_ctzll(m1 | (1ull << 63));
                        int t_hi = m1 ? 127 - __builtin_clzll(m1) : 63 - __builtin_clzll(m0 | 1ull);
                        t_lo = min(t_lo, 4 * qb); t_hi = max(t_hi, 4 * qb + 3);
                        if (bnd > 60.0f && ((t_hi - t_lo + 1) & 1) != 0) { if (t_hi < 127) ++t_hi; else --t_lo; }
                        t_lo = __builtin_amdgcn_readfirstlane(t_lo); t_hi = __builtin_amdgcn_readfirstlane(t_hi);
                        asm volatile("" : "+v"(tidv));
                        if (bnd <= 60.0f)
                        att::attn_diff1(Qb + (row0 + r32) * 1024 + h * 128 + c * 64 + hi * 8, Kb + (size_t)b * SEQ * 1024 + h * 128 + c * 64, Vb + (size_t)b * SEQ * 1024 + h * 128,
                                        (a.pos + oz_) + (size_t)b * SEQ, pq, cneg, (char*)lds, o, tidv, t_lo, t_hi - t_lo + 1, -bnd);
                        else
                        att::attn_pass<4, false, true, 1, false, false>(Qb + (row0 + r32) * 1024 + h * 128 + c * 64 + hi * 8, Kb + (size_t)b * SEQ * 1024 + h * 128 + c * 64, 1024, nullptr,
                                                       Vb + (size_t)b * SEQ * 1024 + h * 128, 1024, (a.pos + oz_) + (size_t)b * SEQ, pq, cneg, (char*)lds, o, tidv, t_lo, t_hi - t_lo + 1, 0.f);
                        if (c == 0) {
#pragma unroll
                            for (int d = 0; d < 4; ++d)
#pragma unroll
                                for (int r = 0; r < 4; ++r) st[d * 4 + r] = (f32x4){o[d][4 * r], o[d][4 * r + 1], o[d][4 * r + 2], o[d][4 * r + 3]};
                        }
                    }
                    float ss[16];
#pragma unroll
                    for (int r = 0; r < 16; ++r) ss[r] = 0.f;
#pragma unroll
                    for (int d = 0; d < 4; ++d)
#pragma unroll
                        for (int r = 0; r < 4; ++r) { const f32x4 s0 = st[d * 4 + r];
#pragma unroll
                            for (int q = 0; q < 4; ++q) { const float v = s0[q] - lam * o[d][4 * r + q]; o[d][4 * r + q] = v; ss[4 * r + q] += v * v; } }
#pragma unroll
                    for (int r = 0; r < 16; ++r) { float v = ss[r]; v += swz_xor<1>(v); v += swz_xor<2>(v); v += swz_xor<4>(v); v += swz_xor<8>(v); v += swz_xor<16>(v); ss[r] = v; }
                    const float* hg = (a.head_g + oz_) + j * 128;
#pragma unroll
                    for (int r = 0; r < 16; ++r) ss[r] = rsqrtf(ss[r] * (1.0f / 128.0f) + EPS) * omli;
                    float* stg = (float*)lds + (size_t)wave * (32 * 68);
#pragma unroll
                    for (int half = 0; half < 2; ++half) {
#pragma unroll
                        for (int r = 0; r < 16; ++r)
#pragma unroll
                            for (int d2 = 0; d2 < 2; ++d2) stg[att::crow(r, hi) * 68 + d2 * 32 + r32] = o[half * 2 + d2][r] * ss[r];
                        asm volatile("s_waitcnt lgkmcnt(0)" ::: "memory");
#pragma unroll
                        for (int i = 0; i < 4; ++i) { const int rw = i * 8 + (lane >> 3), cc = (lane & 7) * 8, col = half * 64 + cc;
                            const f32x4 v0 = *(const f32x4*)(stg + rw * 68 + cc), v1 = *(const f32x4*)(stg + rw * 68 + cc + 4);
                            const size_t off = (row0 + rw) * 1024 + h * 128 + col;
                            const u32x4 g = *(const u32x4*)(Gb + off);
                            const f32x4 g0 = {__uint_as_float(g.x << 16), __uint_as_float(g.x & 0xffff0000u), __uint_as_float(g.y << 16), __uint_as_float(g.y & 0xffff0000u)};
                            const f32x4 g1 = {__uint_as_float(g.z << 16), __uint_as_float(g.z & 0xffff0000u), __uint_as_float(g.w << 16), __uint_as_float(g.w & 0xffff0000u)};
                            const f32x4 h0 = *(const f32x4*)(hg + col), h1 = *(const f32x4*)(hg + col + 4);
                            st8(HO + off, v0 * h0 * g0, v1 * h1 * g1); }
                        asm volatile("s_waitcnt lgkmcnt(0)" ::: "memory");
                    }
                }
            }
            xcd_barrier(xbar);
            {   PH_BEGIN
                unsigned char* wd = ws + WS_WDIFF + (size_t)j * W_DIFF_SZ; const float* xin = (a.out + oz_);
                run_gemm(ldsl, (const bf16*)(ws + WS_HO), 1024, (const bf16*)(wd + W_DIFF_O), 1024, 1024, E4{ws, xin, (a.out + oz_), l}, tid, bxp, Gp);
            }
            xcd_barrier(xbar);
        }
    }
    {
        PH_BEGIN
        for (int m = bxp * 8 + wave; m < M; m += Gp * 8) {
            f32x4* xr = (f32x4*)((a.out + oz_) + (size_t)m * D) + lane; f32x4 v[4]; float s = 0.f;
#pragma unroll
            for (int q = 0; q < 4; ++q) { v[q] = __builtin_nontemporal_load(xr + 64 * q); s += dot4(v[q]); }
            const float r = rsqrtf(wave_sum(s) * (1.0f / D) + EPS);
#pragma unroll
            for (int q = 0; q < 4; ++q) { const f32x4 gg = *(const f32x4*)((a.final_g + oz_) + 4 * lane + 256 * q); __builtin_nontemporal_store((v[q] * r) * gg, xr + 64 * q); }
        }
    }
}

extern "C" void kernel_launch(void* const* d_in, const int* in_sizes, int n_in, void* d_out, int out_size, void* d_ws, size_t ws_size, hipStream_t stream) {
    static int grid_blocks = 0;
    if (grid_blocks == 0) {
        if (n_in != 20 || in_sizes[0] != M * D || out_size != M * D || ws_size < WS_END) { fprintf(stderr, "kernel_launch: unexpected shapes (n_in %d, in0 %d, out %d, ws %zu)\n", n_in, n_in > 0 ? in_sizes[0] : -1, out_size, ws_size); grid_blocks = -1; return; }
        int dev = 0, cus = 0, per_cu = 0;
        hipGetDevice(&dev); hipDeviceGetAttribute(&cus, hipDeviceAttributeMultiprocessorCount, dev);
        if (hipFuncSetAttribute((const void*)fwd_kernel, hipFuncAttributeMaxDynamicSharedMemorySize, LDS_BYTES) != hipSuccess) { fprintf(stderr, "kernel_launch: hipFuncSetAttribute failed\n"); grid_blocks = -1; return; }
        hipOccupancyMaxActiveBlocksPerMultiprocessor(&per_cu, (const void*)fwd_kernel, 512, LDS_BYTES);
        if (per_cu < 1) per_cu = 1;
        grid_blocks = cus * per_cu;
        (void)hipGetLastError();
    }
    if (grid_blocks < 0) return;
    Args a{};
    a.x = (const float*)d_in[0]; a.c = (const float*)d_in[1]; a.pos = (const int*)d_in[2]; a.ada_w = (const float*)d_in[3]; a.ada_b = (const float*)d_in[4]; a.norm_g = (const float*)d_in[5];
    a.mla_w_in = (const float*)d_in[6]; a.mla_qg = (const float*)d_in[7]; a.mla_wq = (const float*)d_in[8]; a.mla_kvg = (const float*)d_in[9]; a.mla_wkv = (const float*)d_in[10]; a.mla_wo = (const float*)d_in[11];
    a.diff_w_in = (const float*)d_in[12]; a.lq1 = (const float*)d_in[13]; a.lk1 = (const float*)d_in[14]; a.lq2 = (const float*)d_in[15]; a.lk2 = (const float*)d_in[16]; a.head_g = (const float*)d_in[17];
    a.diff_wo = (const float*)d_in[18]; a.final_g = (const float*)d_in[19];
    a.out = (float*)d_out; a.ws = (unsigned char*)d_ws;
    void* args[] = {&a};
    hipError_t e = hipLaunchCooperativeKernel((const void*)fwd_kernel, dim3(grid_blocks), dim3(512), args, LDS_BYTES, stream);
    if (e != hipSuccess) fprintf(stderr, "cooperative launch failed: %s (grid %d)\n", hipGetErrorString(e), grid_blocks);
}
```
